# Optimizing an MI355X kernel written in HIP

```python
import math
import jax, jax.numpy as jnp
from jax import lax
import numpy as np

D_MODEL = 1024
BATCH = 4
SEQ = 4096
DEPTH = 4

N_Q_HEADS = 16
N_KV_HEADS = 2
HEAD_DIM = 64
Q_GROUP = N_Q_HEADS // N_KV_HEADS
WINDOW = 128
BLOCK = 128
ATTN_W = N_Q_HEADS * HEAD_DIM
KV_W = N_KV_HEADS * HEAD_DIM
N_BUCKETS = 32
MAX_DISTANCE = 128
LRU_W = D_MODEL
LRU_BLOCKS = 8
LRU_BW = LRU_W // LRU_BLOCKS
CONV_W = 4
LRU_C = 8.0
N_EXPERTS = 16
N_GROUPS = 4
EXPERTS_PER_GROUP = N_EXPERTS // N_GROUPS
TOP_K = 2
EXPERT_FF = 512
ALPHA = (2 * DEPTH) ** 0.25
BETA = (8 * DEPTH) ** -0.25
LN_EPS = 1e-5
IN_SPLITS = (ATTN_W, KV_W, KV_W, LRU_W, LRU_W, D_MODEL, D_MODEL)
IN_W = sum(IN_SPLITS)

kernel_name = "hybrid_swa_rglru_grouped_moe_deepnorm_adaln"


def _layer_norm(x, g, b):
    xf = x.astype(jnp.float32)
    mu = xf.mean(-1, keepdims=True)
    var = jnp.square(xf - mu).mean(-1, keepdims=True)
    return ((xf - mu) * lax.rsqrt(var + LN_EPS) * g + b).astype(x.dtype)


def _t5_causal_bucket(dist):
    max_exact = N_BUCKETS // 2
    d = np.maximum(dist, 0)
    df = np.maximum(d, 1).astype(np.float32)
    large = max_exact + (np.log(df / max_exact) / math.log(MAX_DISTANCE / max_exact)
                         * (N_BUCKETS - max_exact)).astype(np.int32)
    large = np.minimum(large, N_BUCKETS - 1)
    return np.where(d < max_exact, d, large).astype(np.int32)


def _sliding_window_attention(q, k, v, rel_bias, sink):
    b, s, _ = q.shape
    nb = s // BLOCK
    q = q.reshape(b, nb, BLOCK, N_KV_HEADS, Q_GROUP, HEAD_DIM)

    def band(t):
        t = t.reshape(b, nb, BLOCK, N_KV_HEADS, HEAD_DIM)
        prev = jnp.pad(t[:, :-1], ((0, 0), (1, 0), (0, 0), (0, 0), (0, 0)))
        return jnp.concatenate([prev, t], axis=2)

    kb, vb = band(k), band(v)
    logits = jnp.einsum('bnqkgd,bnskd->bnkgqs', q, kb,
                        preferred_element_type=jnp.float32) * (HEAD_DIM ** -0.5)
    qi = np.arange(BLOCK)[:, None]
    sj = np.arange(2 * BLOCK)[None, :]
    dist = qi + BLOCK - sj
    in_window = (dist >= 0) & (dist < WINDOW)
    key_valid = (np.arange(nb)[:, None] * BLOCK - BLOCK + sj) >= 0
    mask = in_window[None] & key_valid[:, None, :]
    bias = rel_bias.astype(jnp.float32)[_t5_causal_bucket(dist)]
    bias = jnp.transpose(bias, (2, 0, 1)).reshape(N_KV_HEADS, Q_GROUP, BLOCK, 2 * BLOCK)
    logits = jnp.where(mask[None, :, None, None], logits + bias, -jnp.inf)
    sink_l = sink.astype(jnp.float32).reshape(N_KV_HEADS, Q_GROUP, 1, 1)
    m = jnp.maximum(logits.max(-1, keepdims=True), sink_l)
    p = jnp.exp(logits - m)
    probs = p / (p.sum(-1, keepdims=True) + jnp.exp(sink_l - m))
    out = jnp.einsum('bnkgqs,bnskd->bnqkgd', probs.astype(v.dtype), vb)
    return out.reshape(b, s, ATTN_W)


def _rg_lru(xb, conv_w, conv_b, wa, ba, wx, bx, lam):
    b, s, w = xb.shape
    xp = jnp.pad(xb, ((0, 0), (CONV_W - 1, 0), (0, 0)))
    xc = conv_b + sum(conv_w[j] * xp[:, j:j + s] for j in range(CONV_W))
    xh = xc.reshape(b, s, LRU_BLOCKS, LRU_BW)
    r = jax.nn.sigmoid(jnp.einsum('bshi,hij->bshj', xh, wa).reshape(b, s, w) + ba)
    i = jax.nn.sigmoid(jnp.einsum('bshi,hij->bshj', xh, wx).reshape(b, s, w) + bx)
    log_a = -LRU_C * r.astype(jnp.float32) * jax.nn.softplus(-lam.astype(jnp.float32))
    a = jnp.exp(log_a)
    inp = jnp.sqrt(-jnp.expm1(2.0 * log_a)) * (i * xc).astype(jnp.float32)

    def combine(lhs, rhs):
        a1, b1 = lhs
        a2, b2 = rhs
        return a1 * a2, a2 * b1 + b2

    _, h = lax.associative_scan(combine, (a, inp), axis=1)
    return h.astype(xb.dtype)


def _grouped_moe(u, router_w, router_b, w_gate, w_up, w_down):
    b, s, d = u.shape
    t = u.reshape(b * s, d)
    logits = jnp.dot(t, router_w, preferred_element_type=jnp.float32) + router_b.astype(jnp.float32)
    scores = jax.nn.softmax(logits, axis=-1)
    grouped = scores.reshape(-1, N_GROUPS, EXPERTS_PER_GROUP)
    group_score = lax.top_k(grouped, TOP_K)[0].sum(-1)
    g_sel = jnp.argmax(group_score, axis=-1)
    in_group = jnp.take_along_axis(grouped, g_sel[:, None, None], axis=1)[:, 0]
    w_top, i_top = lax.top_k(in_group, TOP_K)
    expert_idx = g_sel[:, None] * EXPERTS_PER_GROUP + i_top
    w_top = w_top / w_top.sum(-1, keepdims=True)
    combine = jnp.sum(jax.nn.one_hot(expert_idx, N_EXPERTS, dtype=jnp.float32)
                      * w_top[..., None], axis=1)
    h = jax.nn.silu(jnp.einsum('td,edf->tef', t, w_gate)) * jnp.einsum('td,edf->tef', t, w_up)
    h = h * combine[..., None].astype(h.dtype)
    out = jnp.einsum('tef,efd->td', h, w_down)
    return out.reshape(b, s, d)


def setup_inputs(seed: int = 0) -> dict:
    key = jax.random.key(seed)
    ks = jax.random.split(key, 24)

    def nrm(k, shape, scale):
        return jax.random.normal(k, shape, jnp.float32) * scale

    x = nrm(ks[0], (BATCH, SEQ, D_MODEL), 1.0)
    c = nrm(ks[1], (BATCH, D_MODEL), 1.0)
    ada_w = nrm(ks[2], (DEPTH, D_MODEL, 6 * D_MODEL), D_MODEL ** -0.5)
    ada_b = nrm(ks[3], (DEPTH, 6 * D_MODEL), 0.02)
    w_in = nrm(ks[4], (DEPTH, D_MODEL, IN_W), D_MODEL ** -0.5)
    v_lo = ATTN_W + KV_W
    w_in = w_in.at[:, :, v_lo:v_lo + KV_W].multiply(BETA)
    attn_sink = nrm(ks[5], (DEPTH, N_Q_HEADS), 0.5)
    rel_bias = nrm(ks[6], (N_BUCKETS, N_Q_HEADS), 0.5)
    conv_w = nrm(ks[7], (DEPTH, CONV_W, LRU_W), CONV_W ** -0.5)
    conv_b = nrm(ks[8], (DEPTH, LRU_W), 0.02)
    lru_wa = nrm(ks[9], (DEPTH, LRU_BLOCKS, LRU_BW, LRU_BW), LRU_BW ** -0.5)
    lru_ba = nrm(ks[10], (DEPTH, LRU_W), 0.02)
    lru_wx = nrm(ks[11], (DEPTH, LRU_BLOCKS, LRU_BW, LRU_BW), LRU_BW ** -0.5)
    lru_bx = nrm(ks[12], (DEPTH, LRU_W), 0.02)
    a_c = jax.random.uniform(ks[13], (DEPTH, LRU_W), jnp.float32, minval=0.9, maxval=0.999)
    a0 = a_c ** (1.0 / LRU_C)
    lru_lambda = jnp.log(a0) - jnp.log1p(-a0)
    w_out = nrm(ks[14], (DEPTH, D_MODEL, D_MODEL), D_MODEL ** -0.5 * BETA)
    ln1_g = 1.0 + nrm(ks[15], (DEPTH, D_MODEL), 0.02)
    ln1_b = nrm(ks[16], (DEPTH, D_MODEL), 0.02)
    router_w = nrm(ks[17], (D_MODEL, N_EXPERTS), D_MODEL ** -0.5)
    router_b = nrm(ks[18], (N_EXPERTS,), 0.01)
    moe_w_gate = nrm(ks[19], (DEPTH, N_EXPERTS, D_MODEL, EXPERT_FF), D_MODEL ** -0.5)
    moe_w_up = nrm(ks[20], (DEPTH, N_EXPERTS, D_MODEL, EXPERT_FF), D_MODEL ** -0.5)
    moe_w_down = nrm(ks[21], (DEPTH, N_EXPERTS, EXPERT_FF, D_MODEL), EXPERT_FF ** -0.5 * BETA)
    ln2_g = 1.0 + nrm(ks[22], (DEPTH, D_MODEL), 0.02)
    ln2_b = nrm(ks[23], (DEPTH, D_MODEL), 0.02)
    return {"x": x, "c": c, "ada_w": ada_w, "ada_b": ada_b, "w_in": w_in,
            "attn_sink": attn_sink, "rel_bias": rel_bias, "conv_w": conv_w, "conv_b": conv_b,
            "lru_wa": lru_wa, "lru_ba": lru_ba, "lru_wx": lru_wx, "lru_bx": lru_bx,
            "lru_lambda": lru_lambda, "w_out": w_out, "ln1_g": ln1_g, "ln1_b": ln1_b,
            "router_w": router_w, "router_b": router_b, "moe_w_gate": moe_w_gate,
            "moe_w_up": moe_w_up, "moe_w_down": moe_w_down, "ln2_g": ln2_g, "ln2_b": ln2_b}


def reference(x, c, ada_w, ada_b, w_in, attn_sink, rel_bias, conv_w, conv_b,
              lru_wa, lru_ba, lru_wx, lru_bx, lru_lambda, w_out, ln1_g, ln1_b,
              router_w, router_b, moe_w_gate, moe_w_up, moe_w_down, ln2_g, ln2_b):
    split_at = np.cumsum(IN_SPLITS)[:-1].tolist()
    c_act = jax.nn.silu(c)
    for l in range(DEPTH):
        mod = (c_act @ ada_w[l] + ada_b[l])[:, None, :]
        shift1, scale1, gate1, shift2, scale2, gate2 = jnp.split(mod, 6, axis=-1)
        u = x * (1.0 + scale1) + shift1
        q, k, v, lru_x, lru_gate, gate_a, gate_b = jnp.split(u @ w_in[l], split_at, axis=-1)
        y_a = _sliding_window_attention(q, k, v, rel_bias, attn_sink[l])
        y_b = _rg_lru(lru_x, conv_w[l], conv_b[l], lru_wa[l], lru_ba[l], lru_wx[l], lru_bx[l],
                      lru_lambda[l]) * jax.nn.gelu(lru_gate)
        y = jax.nn.sigmoid(gate_a) * y_a + jax.nn.sigmoid(gate_b) * y_b
        x = _layer_norm(ALPHA * x + gate1 * (y @ w_out[l]), ln1_g[l], ln1_b[l])
        u = x * (1.0 + scale2) + shift2
        f = _grouped_moe(u, router_w, router_b, moe_w_gate[l], moe_w_up[l], moe_w_down[l])
        x = _layer_norm(ALPHA * x + gate2 * f, ln2_g[l], ln2_b[l])
    return x
```

```cpp
#include <hip/hip_runtime.h>
#include <cstdio>
#include <cstdint>

typedef unsigned short bf16;
constexpr int T = 16384, D = 1024, SEQ = 4096, NB = 4, INW = 5376, NL = 4;
constexpr int C_Q = 0, C_K = 1024, C_V = 1152, C_LX = 1280, C_LG = 2304, C_GA = 3328, C_GB = 4352;
constexpr int NE = 16, FF = 512;
constexpr float ALPHA = 1.681792830507429f;
constexpr float LN_EPS = 1e-5f;
constexpr size_t MiB = 1u << 20;
constexpr size_t WS_CTL = 0;
constexpr size_t WS_MOD = 1 * MiB;
constexpr size_t WS_EIDX = 3 * MiB;
constexpr size_t WS_EW = 4 * MiB;
constexpr size_t WS_WREG = 8 * MiB;
constexpr size_t WS_U = 250 * MiB;
constexpr size_t WS_P = 282 * MiB;
constexpr size_t WS_Y = 450 * MiB;
constexpr size_t WS_H = 482 * MiB;
constexpr size_t WS_END = 518 * MiB;
constexpr size_t WS_TA = WS_WREG;
constexpr size_t WS_TI = WS_WREG + 64 * MiB;
constexpr size_t WS_TZ = WS_WREG + 128 * MiB;

__device__ __forceinline__ float bf2f(bf16 v) { return __uint_as_float((unsigned)v << 16); }
__device__ __forceinline__ bf16 f2bf(float f) { unsigned u = __float_as_uint(f); return (bf16)((u + 0x7fffu + ((u >> 16) & 1u)) >> 16); }
__device__ __forceinline__ float sigmoidf_(float x) { return 1.f / (1.f + __expf(-x)); }
__device__ __forceinline__ float siluf_(float x) { return x / (1.f + __expf(-x)); }
__device__ __forceinline__ float gelu_tanh(float x) { const float k = 0.7978845608028654f; float u = k * (x + 0.044715f * x * x * x); return 0.5f * x * (1.f + tanhf(u)); }

__constant__ int c_bucket[128] = {0, 1, 2, 3, 4, 5, 6, 7, 8, 9, 10, 11, 12, 13, 14, 15, 16, 16, 16, 17, 17, 18, 18, 18, 19, 19, 19, 20, 20, 20, 20, 21, 21, 21, 21, 22, 22, 22, 22, 22, 23, 23, 23, 23, 23, 23, 24, 24, 24, 24, 24, 24, 25, 25, 25, 25, 25, 25, 25, 26, 26, 26, 26, 26, 26, 26, 26, 27, 27, 27, 27, 27, 27, 27, 27, 27, 27, 28, 28, 28, 28, 28, 28, 28, 28, 28, 28, 29, 29, 29, 29, 29, 29, 29, 29, 29, 29, 29, 29, 30, 30, 30, 30, 30, 30, 30, 30, 30, 30, 30, 30, 30, 30, 31, 31, 31, 31, 31, 31, 31, 31, 31, 31, 31, 31, 31, 31, 31};

__global__ void __launch_bounds__(256) k_mod(const float* c, const float* ada_w, const float* ada_b, float* mod) {
    __shared__ float ca[NB * D];
    for (int i = threadIdx.x; i < NB * D; i += 256) ca[i] = siluf_(c[i]);
    __syncthreads();
    const int gid = blockIdx.x * 256 + threadIdx.x;
    const int l = gid / 6144, j = gid % 6144;
    float acc[NB] = {0.f, 0.f, 0.f, 0.f};
    const float* w = ada_w + (size_t)l * D * 6144 + j;
    for (int k = 0; k < D; ++k) { const float wv = w[(size_t)k * 6144];
#pragma unroll
        for (int b = 0; b < NB; ++b) acc[b] += ca[b * D + k] * wv; }
#pragma unroll
    for (int b = 0; b < NB; ++b) mod[((size_t)l * NB + b) * 6144 + j] = acc[b] + ada_b[l * 6144 + j];
}
__global__ void __launch_bounds__(256) k_modulate(const float* x, const float* mod_l, bf16* u, int sh_off, int sc_off) {
    const size_t i = (size_t)blockIdx.x * 256 + threadIdx.x; const int t = (int)(i / D), d = (int)(i % D), b = t / SEQ;
    const float* m = mod_l + (size_t)b * 6144;
    u[i] = f2bf(x[i] * (1.f + m[sc_off + d]) + m[sh_off + d]);
}
template <bool OUT_BF16>
__global__ void __launch_bounds__(256) k_sgemm(const bf16* A, const float* B, void* C, int M, int N, int K) {
    __shared__ float As[16][64 + 4], Bs[16][64 + 4];
    const int tx = threadIdx.x % 16, ty = threadIdx.x / 16;
    const int m0 = blockIdx.y * 64, n0 = blockIdx.x * 64;
    float acc[4][4] = {};
    for (int k0 = 0; k0 < K; k0 += 16) {
        {
            const int r = threadIdx.x / 4, c4 = (threadIdx.x % 4) * 4;
            const bf16* ap = A + (size_t)(m0 + r) * K + k0 + c4;
#pragma unroll
            for (int i = 0; i < 4; ++i) As[c4 + i][r] = bf2f(ap[i]);
        }
        {
            const int r = threadIdx.x / 16, c4 = (threadIdx.x % 16) * 4;
            const float* bp = B + (size_t)(k0 + r) * N + n0 + c4;
#pragma unroll
            for (int i = 0; i < 4; ++i) Bs[r][c4 + i] = bp[i];
        }
        __syncthreads();
#pragma unroll
        for (int kk = 0; kk < 16; ++kk) {
            float a[4], b[4];
#pragma unroll
            for (int i = 0; i < 4; ++i) { a[i] = As[kk][ty * 4 + i]; b[i] = Bs[kk][tx * 4 + i]; }
#pragma unroll
            for (int i = 0; i < 4; ++i)
#pragma unroll
                for (int j = 0; j < 4; ++j) acc[i][j] += a[i] * b[j];
        }
        __syncthreads();
    }
#pragma unroll
    for (int i = 0; i < 4; ++i)
#pragma unroll
        for (int j = 0; j < 4; ++j) {
            const size_t o = (size_t)(m0 + ty * 4 + i) * N + n0 + tx * 4 + j;
            if (OUT_BF16) ((bf16*)C)[o] = f2bf(acc[i][j]); else ((float*)C)[o] = acc[i][j];
        }
}
__global__ void __launch_bounds__(256) k_attn(const bf16* P, const float* rel_bias, const float* sink_l, bf16* ya) {
    __shared__ float qs[4][64]; __shared__ float ps[4][128];
    const int w = threadIdx.x / 64, lane = threadIdx.x % 64;
    const int gw = blockIdx.x * 4 + w; const int t = gw / 16, h = gw % 16, kvh = h / 8;
    const int s = t % SEQ;
    qs[w][lane] = bf2f(P[(size_t)t * INW + C_Q + h * 64 + lane]);
    __syncthreads();
    float lg[2];
#pragma unroll
    for (int r = 0; r < 2; ++r) {
        const int dist = lane + 64 * r; const int pos = s - dist;
        if (pos >= 0) {
            const bf16* kp = P + (size_t)(t - dist) * INW + C_K + kvh * 64;
            float acc = 0.f;
            for (int d = 0; d < 64; ++d) acc += qs[w][d] * bf2f(kp[d]);
            lg[r] = acc * 0.125f + rel_bias[c_bucket[dist] * 16 + h];
        } else lg[r] = -INFINITY;
    }
    const float sk = sink_l[h];
    float m = fmaxf(fmaxf(lg[0], lg[1]), sk);
    for (int o = 1; o < 64; o <<= 1) m = fmaxf(m, __shfl_xor(m, o));
    const float p0 = __expf(lg[0] - m), p1 = __expf(lg[1] - m);
    float sum = p0 + p1;
    for (int o = 1; o < 64; o <<= 1) sum += __shfl_xor(sum, o);
    const float inv = 1.f / (sum + __expf(sk - m));
    ps[w][lane] = p0 * inv; ps[w][lane + 64] = p1 * inv;
    __syncthreads();
    float acc = 0.f;
    const int nk = (s + 1 < 128) ? s + 1 : 128;
    for (int dist = 0; dist < nk; ++dist) acc += ps[w][dist] * bf2f(P[(size_t)(t - dist) * INW + C_V + kvh * 64 + lane]);
    ya[(size_t)t * D + h * 64 + lane] = f2bf(acc);
}
__global__ void __launch_bounds__(128) k_lru_gates(const bf16* P, const float* conv_w, const float* conv_b, const float* wa, const float* ba, const float* wx, const float* bx,
                                                    const float* lam, float* A_out, float* I_out) {
    __shared__ float xc[128];
    const int t = blockIdx.x / 8, hb = blockIdx.x % 8, j = threadIdx.x, ch = hb * 128 + j, s = t % SEQ;
    float v = conv_b[ch];
#pragma unroll
    for (int q = 0; q < 4; ++q) { const int back = 3 - q; if (s - back >= 0) v += conv_w[q * D + ch] * bf2f(P[(size_t)(t - back) * INW + C_LX + ch]); }
    xc[j] = v;
    __syncthreads();
    float r = 0.f, ii = 0.f;
    const float* wap = wa + (size_t)hb * 128 * 128 + j; const float* wxp = wx + (size_t)hb * 128 * 128 + j;
    for (int i = 0; i < 128; ++i) { r += xc[i] * wap[i * 128]; ii += xc[i] * wxp[i * 128]; }
    r = sigmoidf_(r + ba[ch]); ii = sigmoidf_(ii + bx[ch]);
    const float sp = log1pf(expf(-lam[ch]));
    const float log_a = -8.0f * r * sp;
    const float a = expf(log_a);
    const float inp = sqrtf(-expm1f(2.0f * log_a)) * (ii * v);
    A_out[(size_t)t * D + ch] = a; I_out[(size_t)t * D + ch] = inp;
}
__global__ void __launch_bounds__(64) k_lru_scan(const float* A_in, float* I_io) {
    const int gid = blockIdx.x * 64 + threadIdx.x; const int b = gid / D, ch = gid % D;
    float h = 0.f;
#pragma unroll 8
    for (int s = 0; s < SEQ; ++s) { const size_t o = ((size_t)b * SEQ + s) * D + ch; h = A_in[o] * h + I_io[o]; I_io[o] = h; }
}
__global__ void __launch_bounds__(256) k_merge(const bf16* P, const float* Hs, bf16* y) {
    const size_t i = (size_t)blockIdx.x * 256 + threadIdx.x; const int t = (int)(i / D), d = (int)(i % D);
    const bf16* pr = P + (size_t)t * INW;
    const float ya = bf2f(y[i]);
    const float yb = Hs[i] * gelu_tanh(bf2f(pr[C_LG + d]));
    y[i] = f2bf(sigmoidf_(bf2f(pr[C_GA + d])) * ya + sigmoidf_(bf2f(pr[C_GB + d])) * yb);
}
__device__ __forceinline__ float block_sum256(float v, float* red) {
    for (int o = 1; o < 64; o <<= 1) v += __shfl_xor(v, o);
    __syncthreads();
    if ((threadIdx.x & 63) == 0) red[threadIdx.x >> 6] = v;
    __syncthreads();
    return red[0] + red[1] + red[2] + red[3];
}
__global__ void __launch_bounds__(256) k_ln1(const float* xin, float* xout, const float* Z, const float* mod_l, const float* g, const float* bta, const float* router_w, const float* router_b,
                                              bf16* u2, int* eidx, float* ew) {
    __shared__ float red[4]; __shared__ float lgs[4][16];
    const int t = blockIdx.x, b = t / SEQ, tid = threadIdx.x;
    const float* m = mod_l + (size_t)b * 6144;
    float v[4]; float s = 0.f;
#pragma unroll
    for (int i = 0; i < 4; ++i) { const int d = tid + 256 * i; v[i] = ALPHA * xin[(size_t)t * D + d] + m[2048 + d] * Z[(size_t)t * D + d]; s += v[i]; }
    const float mean = block_sum256(s, red) * (1.f / D);
    float q = 0.f;
#pragma unroll
    for (int i = 0; i < 4; ++i) { v[i] -= mean; q += v[i] * v[i]; }
    const float rstd = rsqrtf(block_sum256(q, red) * (1.f / D) + LN_EPS);
    float lg[16];
#pragma unroll
    for (int e = 0; e < 16; ++e) lg[e] = 0.f;
#pragma unroll
    for (int i = 0; i < 4; ++i) { const int d = tid + 256 * i; const float xn = v[i] * rstd * g[d] + bta[d]; xout[(size_t)t * D + d] = xn;
        const float uu = xn * (1.f + m[4096 + d]) + m[3072 + d]; u2[(size_t)t * D + d] = f2bf(uu);
#pragma unroll
        for (int e = 0; e < 16; ++e) lg[e] += uu * router_w[d * 16 + e]; }
#pragma unroll
    for (int e = 0; e < 16; ++e) { float x = lg[e]; for (int o = 1; o < 64; o <<= 1) x += __shfl_xor(x, o); lg[e] = x; }
    __syncthreads();
    if ((tid & 63) == 0) {
#pragma unroll
        for (int e = 0; e < 16; ++e) lgs[tid >> 6][e] = lg[e]; }
    __syncthreads();
    if (tid == 0) {
        float sc[16]; float mx = -INFINITY;
#pragma unroll
        for (int e = 0; e < 16; ++e) { sc[e] = lgs[0][e] + lgs[1][e] + lgs[2][e] + lgs[3][e] + router_b[e]; mx = fmaxf(mx, sc[e]); }
        float sum = 0.f;
#pragma unroll
        for (int e = 0; e < 16; ++e) { sc[e] = expf(sc[e] - mx); sum += sc[e]; }
#pragma unroll
        for (int e = 0; e < 16; ++e) sc[e] /= sum;
        int gsel = 0; float best = -1.f; int bi0 = 0, bi1 = 1; float bw0 = 0.f, bw1 = 0.f;
#pragma unroll
        for (int gI = 0; gI < 4; ++gI) {
            int i0 = 0; float w0 = sc[gI * 4];
#pragma unroll
            for (int k = 1; k < 4; ++k) if (sc[gI * 4 + k] > w0) { w0 = sc[gI * 4 + k]; i0 = k; }
            int i1 = -1; float w1 = -1.f;
#pragma unroll
            for (int k = 0; k < 4; ++k) if (k != i0 && sc[gI * 4 + k] > w1) { w1 = sc[gI * 4 + k]; i1 = k; }
            const float gs = w0 + w1;
            if (gs > best) { best = gs; gsel = gI; bi0 = i0; bi1 = i1; bw0 = w0; bw1 = w1; }
        }
        const float ws = bw0 + bw1;
        eidx[t * 2 + 0] = gsel * 4 + bi0; eidx[t * 2 + 1] = gsel * 4 + bi1;
        ew[t * 2 + 0] = bw0 / ws; ew[t * 2 + 1] = bw1 / ws;
    }
}
__global__ void __launch_bounds__(512) k_moe_h(const bf16* u2, const int* eidx, const float* ew, const float* wg, const float* wu, float* hm) {
    __shared__ float us[D];
    const int t = blockIdx.x, f = threadIdx.x;
    for (int i = f; i < D; i += 512) us[i] = bf2f(u2[(size_t)t * D + i]);
    __syncthreads();
#pragma unroll
    for (int k = 0; k < 2; ++k) {
        const int e = eidx[t * 2 + k];
        const float* g = wg + (size_t)e * D * FF + f; const float* u = wu + (size_t)e * D * FF + f;
        float ag = 0.f, au = 0.f;
        for (int d = 0; d < D; ++d) { ag += us[d] * g[(size_t)d * FF]; au += us[d] * u[(size_t)d * FF]; }
        hm[((size_t)t * 2 + k) * FF + f] = siluf_(ag) * au * ew[t * 2 + k];
    }
}
__global__ void __launch_bounds__(256) k_moe_out_ln2(float* x, const float* hm, const int* eidx, const float* wd, const float* mod_l, const float* g, const float* bta,
                                                      const float* mod_next, bf16* unext) {
    __shared__ float hs[2 * FF]; __shared__ float red[4];
    const int t = blockIdx.x, b = t / SEQ, tid = threadIdx.x;
    for (int i = tid; i < 2 * FF; i += 256) hs[i] = hm[(size_t)t * 2 * FF + i];
    __syncthreads();
    float acc[4] = {0.f, 0.f, 0.f, 0.f};
#pragma unroll
    for (int k = 0; k < 2; ++k) {
        const int e = eidx[t * 2 + k]; const float* w = wd + (size_t)e * FF * D;
        for (int f = 0; f < FF; ++f) { const float hv = hs[k * FF + f];
#pragma unroll
            for (int i = 0; i < 4; ++i) acc[i] += hv * w[(size_t)f * D + tid + 256 * i]; }
    }
    const float* m = mod_l + (size_t)b * 6144;
    float v[4]; float s = 0.f;
#pragma unroll
    for (int i = 0; i < 4; ++i) { const int d = tid + 256 * i; v[i] = ALPHA * x[(size_t)t * D + d] + m[5120 + d] * acc[i]; s += v[i]; }
    const float mean = block_sum256(s, red) * (1.f / D);
    float q = 0.f;
#pragma unroll
    for (int i = 0; i < 4; ++i) { v[i] -= mean; q += v[i] * v[i]; }
    const float rstd = rsqrtf(block_sum256(q, red) * (1.f / D) + LN_EPS);
#pragma unroll
    for (int i = 0; i < 4; ++i) { const int d = tid + 256 * i; const float xn = v[i] * rstd * g[d] + bta[d]; x[(size_t)t * D + d] = xn;
        if (mod_next) { const float* mn = mod_next + (size_t)b * 6144; unext[(size_t)t * D + d] = f2bf(xn * (1.f + mn[1024 + d]) + mn[d]); } }
}

extern "C" void kernel_launch(void* const* d_in, const int* in_sizes, int n_in, void* d_out, int out_size, void* d_ws, size_t ws_size, hipStream_t stream) {
    if (n_in != 24 || ws_size < WS_END) { fprintf(stderr, "kernel_launch: bad args n_in=%d ws=%zu\n", n_in, ws_size); return; }
    const float* x = (const float*)d_in[0]; const float* c = (const float*)d_in[1]; const float* ada_w = (const float*)d_in[2]; const float* ada_b = (const float*)d_in[3];
    const float* w_in = (const float*)d_in[4]; const float* attn_sink = (const float*)d_in[5]; const float* rel_bias = (const float*)d_in[6];
    const float* conv_w = (const float*)d_in[7]; const float* conv_b = (const float*)d_in[8]; const float* lru_wa = (const float*)d_in[9]; const float* lru_ba = (const float*)d_in[10];
    const float* lru_wx = (const float*)d_in[11]; const float* lru_bx = (const float*)d_in[12]; const float* lru_lambda = (const float*)d_in[13]; const float* w_out = (const float*)d_in[14];
    const float* ln1_g = (const float*)d_in[15]; const float* ln1_b = (const float*)d_in[16]; const float* router_w = (const float*)d_in[17]; const float* router_b = (const float*)d_in[18];
    const float* moe_wg = (const float*)d_in[19]; const float* moe_wu = (const float*)d_in[20]; const float* moe_wd = (const float*)d_in[21];
    const float* ln2_g = (const float*)d_in[22]; const float* ln2_b = (const float*)d_in[23];
    unsigned char* ws = (unsigned char*)d_ws; float* out = (float*)d_out;
    float* mod = (float*)(ws + WS_MOD); int* eidx = (int*)(ws + WS_EIDX); float* ew = (float*)(ws + WS_EW);
    bf16* U = (bf16*)(ws + WS_U); bf16* P = (bf16*)(ws + WS_P); bf16* Y = (bf16*)(ws + WS_Y);
    float* TA = (float*)(ws + WS_TA); float* TI = (float*)(ws + WS_TI); float* TZ = (float*)(ws + WS_TZ);
    k_mod<<<NL * 6144 / 256, 256, 0, stream>>>(c, ada_w, ada_b, mod);
    k_modulate<<<T * D / 256, 256, 0, stream>>>(x, mod, U, 0, 1024);
    for (int l = 0; l < NL; ++l) {
        const float* mod_l = mod + (size_t)l * NB * 6144;
        const float* xin = (l == 0) ? x : out;
        k_sgemm<true><<<dim3(INW / 64, T / 64), 256, 0, stream>>>(U, w_in + (size_t)l * D * INW, P, T, INW, D);
        k_attn<<<T * 16 / 4, 256, 0, stream>>>(P, rel_bias, attn_sink + l * 16, Y);
        k_lru_gates<<<T * 8, 128, 0, stream>>>(P, conv_w + (size_t)l * 4 * D, conv_b + l * D, lru_wa + (size_t)l * 8 * 128 * 128, lru_ba + l * D, lru_wx + (size_t)l * 8 * 128 * 128, lru_bx + l * D,
                                              lru_lambda + l * D, TA, TI);
        k_lru_scan<<<NB * D / 64, 64, 0, stream>>>(TA, TI);
        k_merge<<<T * D / 256, 256, 0, stream>>>(P, TI, Y);
        k_sgemm<false><<<dim3(D / 64, T / 64), 256, 0, stream>>>(Y, w_out + (size_t)l * D * D, TZ, T, D, D);
        k_ln1<<<T, 256, 0, stream>>>(xin, out, TZ, mod_l, ln1_g + l * D, ln1_b + l * D, router_w, router_b, U, eidx, ew);
        k_moe_h<<<T, 512, 0, stream>>>(U, eidx, ew, moe_wg + (size_t)l * NE * D * FF, moe_wu + (size_t)l * NE * D * FF, TZ);
        k_moe_out_ln2<<<T, 256, 0, stream>>>(out, TZ, eidx, moe_wd + (size_t)l * NE * FF * D, mod_l, ln2_g + l * D, ln2_b + l * D,
                                             (l + 1 < NL) ? mod + (size_t)(l + 1) * NB * 6144 : nullptr, U);
    }
}
```

```cpp
#include <hip/hip_runtime.h>
#include <cstdio>
#include <cstdint>
#define MK_SPLIT 0
namespace pg8 {
#define PG8_LAS __attribute__((address_space(3)))
typedef unsigned short bf16_t;
typedef short bf16x8 __attribute__((ext_vector_type(8)));
typedef float f32x4 __attribute__((ext_vector_type(4)));
typedef unsigned u32x4 __attribute__((ext_vector_type(4)));
constexpr int BM = 256, BK = 64, HALF = 128, HTB = HALF * BK * 2  , STAGE_BYTES = 8 * HTB, NXCD = 8, WGM = 8;

__host__ __device__ __forceinline__ int lds_byte(int r, int c) { const int st = (r >> 4) * 2 + (c >> 5), rr = r & 15, cc = c & 31, ob = rr * 64 + cc * 2; return st * 1024 + (ob ^ (((ob >> 9) & 1) << 5)); }
__host__ __device__ __forceinline__ void stage_rc(int b, int& R, int& C) { const int st = b / 1024, sb = b % 1024, swz = sb ^ (((sb >> 9) & 1) << 5); R = (st >> 1) * 16 + swz / 64; C = (st & 1) * 32 + (swz % 64) / 2; }
__host__ __device__ __forceinline__ int perm32(int rho) { const int n = rho >> 4, i = rho & 15; return 8 * (i >> 2) + 4 * n + (i & 3); }

struct Unit { int pm, pn, e, mt, nv; };
struct Gemm { const bf16_t* A; const bf16_t* Bt; int M, N, K; };

struct StaticOrder {
    int nM, nN, nwg, G, c;
    __host__ __device__ void init(int M, int N, int G_, int c_) { nM = M / BM; nN = N / BM; nwg = nM * nN; G = G_; c = c_; }
    __host__ __device__ bool next(int i, Unit& u) const {
        const long L = (long)i * G + c; if (L >= nwg) return false;
        int wgid = (int)L; { const int q = nwg / NXCD, r = nwg % NXCD, xcd = wgid % NXCD, off = wgid / NXCD; wgid = (xcd < r ? xcd * (q + 1) : r * (q + 1) + (xcd - r) * q) + off; }
        const int nig = WGM * nN, gid = wgid / nig, fm = gid * WGM, gsz = (nM - fm) < WGM ? (nM - fm) : WGM;
        u.pm = fm + ((wgid % nig) % gsz); u.pn = (wgid % nig) / gsz; u.e = 0; u.mt = 0; u.nv = 256; return true;
    }
    __device__ __forceinline__ void a_ready(const Unit&) const {}
    __device__ __forceinline__ void done(const Unit&) const {}
};

__device__ __forceinline__ unsigned cvt_pk_bf16(float lo, float hi) { unsigned r; asm volatile("v_cvt_pk_bf16_f32 %0, %1, %2" : "=v"(r) : "v"(lo), "v"(hi)); return r; }
typedef float f32x2 __attribute__((ext_vector_type(2)));
__device__ __forceinline__ f32x2 gelu_pk(f32x2 v) {
    const f32x2 av = __builtin_elementwise_abs(v), d = av * 0.2316418882f + 1.0f;
    f32x2 t; t.x = __builtin_amdgcn_rcpf(d.x); t.y = __builtin_amdgcn_rcpf(d.y);
    f32x2 q = t * 0.5307027145f + (-0.7265760135f); q = q * t + 0.7107068705f; q = q * t + (-0.142248368f); q = q * t + 0.127414796f; q = q * t;
    const f32x2 s = (v * v) * (-0.72134752044f);
    f32x2 e; e.x = __builtin_amdgcn_exp2f(s.x); e.y = __builtin_amdgcn_exp2f(s.y);
    const f32x2 m = v * (q * e), r = v - m;
    f32x2 o; o.x = v.x < 0.f ? m.x : r.x; o.y = v.y < 0.f ? m.y : r.y; return o;
}

struct EpiStoreBf16 {
    static constexpr bool PERM = true, AFTER_DRAIN = false;
    bf16_t* O; int ldc;
    __device__ __forceinline__ void operator()(const f32x4 (&acc)[2][2][4][2], const Unit& u, int wr, int wc, int fr, int fq) const {
        const int row0 = u.pm * BM + wr * 64 + fr, col0 = u.pn * BM + wc * 32 + 8 * fq;
#pragma unroll
        for (int ai = 0; ai < 2; ++ai)
#pragma unroll
            for (int m = 0; m < 4; ++m) { bf16_t* rowp = O + (size_t)(row0 + ai * HALF + m * 16) * ldc + col0;
#pragma unroll
                for (int bj = 0; bj < 2; ++bj) { const f32x4 v0 = acc[ai][bj][m][0], v1 = acc[ai][bj][m][1];
                    u32x4 w; w.x = cvt_pk_bf16(v0[0], v0[1]); w.y = cvt_pk_bf16(v0[2], v0[3]); w.z = cvt_pk_bf16(v1[0], v1[1]); w.w = cvt_pk_bf16(v1[2], v1[3]);
                    *(u32x4*)(rowp + bj * HALF) = w; } }
    }
};
__device__ __forceinline__ float silu_f(float x) { return x * __builtin_amdgcn_rcpf(1.0f + __builtin_amdgcn_exp2f(-1.4426950408889634f * x)); }
struct EpiMoeGU {
    static constexpr bool PERM = true, AFTER_DRAIN = false;
    bf16_t* H;
    __device__ __forceinline__ void operator()(const f32x4 (&acc)[2][2][4][2], const Unit& u, int wr, int wc, int fr, int fq) const {
        const int row0 = u.pm * BM + wr * 64 + fr, hc0 = (u.pn & 3) * 128 + wc * 32 + 8 * fq;
#pragma unroll
        for (int ai = 0; ai < 2; ++ai)
#pragma unroll
            for (int m = 0; m < 4; ++m) { bf16_t* rowp = H + (size_t)(row0 + ai * HALF + m * 16) * 512 + hc0;
                const f32x4 g0 = acc[ai][0][m][0], g1 = acc[ai][0][m][1], u0 = acc[ai][1][m][0], u1 = acc[ai][1][m][1];
                u32x4 w; w.x = cvt_pk_bf16(silu_f(g0[0]) * u0[0], silu_f(g0[1]) * u0[1]); w.y = cvt_pk_bf16(silu_f(g0[2]) * u0[2], silu_f(g0[3]) * u0[3]);
                w.z = cvt_pk_bf16(silu_f(g1[0]) * u1[0], silu_f(g1[1]) * u1[1]); w.w = cvt_pk_bf16(silu_f(g1[2]) * u1[2], silu_f(g1[3]) * u1[3]);
                *(u32x4*)rowp = w; }
    }
};
struct EpiMoeDown {
    static constexpr bool PERM = true, AFTER_DRAIN = false;
    bf16_t* F; const int* list; int T;
    __device__ __forceinline__ void operator()(const f32x4 (&acc)[2][2][4][2], const Unit& u, int wr, int wc, int fr, int fq) const {
        const int* lb = list + u.e * 16384 + u.mt * BM; const int col0 = (u.pn & 3) * BM + wc * 32 + 8 * fq;
#pragma unroll
        for (int ai = 0; ai < 2; ++ai)
#pragma unroll
            for (int m = 0; m < 4; ++m) { const int rl = ai * HALF + wr * 64 + m * 16 + fr;
                if (rl < u.nv) { const int ent = lb[rl]; bf16_t* rowp = F + ((size_t)(ent & 1) * T + (ent >> 1)) * 1024 + col0;
#pragma unroll
                    for (int bj = 0; bj < 2; ++bj) { const f32x4 v0 = acc[ai][bj][m][0], v1 = acc[ai][bj][m][1];
                        u32x4 w; w.x = cvt_pk_bf16(v0[0], v0[1]); w.y = cvt_pk_bf16(v0[2], v0[3]); w.z = cvt_pk_bf16(v1[0], v1[1]); w.w = cvt_pk_bf16(v1[2], v1[3]);
                        *(u32x4*)(rowp + bj * HALF) = w; } } }
    }
};
struct MoeOrder {
    const PG8_LAS int* cntl; const int* list; int G, c;
    __device__ __forceinline__ bool next(int i, Unit& u) const {
        const int L = i * G + c, tile = L >> 2; int acc = 0;
#pragma unroll 1
        for (int e = 0; e < 16; ++e) { const int ce = cntl[e], nte = (ce + BM - 1) >> 8;
            if (tile < acc + nte) { u.e = e; u.mt = tile - acc; u.pm = tile; u.pn = e * 4 + (L & 3); const int rem = ce - u.mt * BM; u.nv = rem < BM ? rem : BM; return true; }
            acc += nte; }
        return false;
    }
    __device__ __forceinline__ int gather_row(const Unit& u, int r) const { const int* lb = list + u.e * 16384 + u.mt * BM; return lb[r < u.nv ? r : 0] >> 1; }
    __device__ __forceinline__ void a_ready(const Unit&) const {}
    __device__ __forceinline__ void done(const Unit&) const {}
};

template <class Epi, class Sched, bool ALIGN_EPI, bool GATHER>
__device__ __forceinline__ void gemm_phase(PG8_LAS unsigned char* lds, const Gemm g, const Sched& S, const Epi& E, const int tid) {
    const int wid = __builtin_amdgcn_readfirstlane(tid >> 6), lane = tid & 63, wr = wid >> 2, wc = wid & 3, fr = lane & 15, fq = lane >> 4;
    const int K = g.K, nt = K / BK;
    unsigned voffB[2], vC[2][2], vN[2][2]; int stR[2], stC[2];
#pragma unroll
    for (int i = 0; i < 2; ++i) { int R, C; stage_rc(tid * 16 + i * 8192, R, C); stR[i] = R; stC[i] = C; const int Rb = Epi::PERM ? ((R & ~31) + perm32(R & 31)) : R;
        voffB[i] = (unsigned)(Rb * K + C) * 2u; }
    const size_t kstep = (size_t)(BK * 2);
    const size_t hstep = (size_t)HALF * K * 2;
    const size_t tstep = 2 * hstep;
    const unsigned ldsw = (unsigned)wid * 1024u;
    const int aoff = lds_byte(wr * 64 + fr, fq * 8), boff = lds_byte(wc * 32 + fr, fq * 8);
#define PG8_SA(b, h) (((b) * 2 + (h)) * HTB)
#define PG8_SB(b, h) ((4 + (b) * 2 + (h)) * HTB)
#define PG8_STAGE(bufoff, gbase, voff) do { _Pragma("unroll") for (int _i = 0; _i < 2; ++_i) \
        __builtin_amdgcn_global_load_lds((const unsigned*)((const char*)(gbase) + (voff)[_i]), (PG8_LAS unsigned*)(lds + (bufoff) + ldsw + _i * 8192), 16, 0, 0); } while (0)
#define PG8_LDA(dst, b, h) do { _Pragma("unroll") for (int m = 0; m < 4; ++m) _Pragma("unroll") for (int k = 0; k < 2; ++k) dst[m][k] = *(const PG8_LAS bf16x8*)(lds + PG8_SA(b, h) + aoff + m * 2048 + k * 1024); } while (0)
#define PG8_LDB(dst, b, h) do { _Pragma("unroll") for (int n = 0; n < 2; ++n) _Pragma("unroll") for (int k = 0; k < 2; ++k) dst[n][k] = *(const PG8_LAS bf16x8*)(lds + PG8_SB(b, h) + boff + n * 2048 + k * 1024); } while (0)
#define PG8_MMA(ai, bj, At, Bt) do { __builtin_amdgcn_s_setprio(1); _Pragma("unroll") for (int m = 0; m < 4; ++m) _Pragma("unroll") for (int n = 0; n < 2; ++n) _Pragma("unroll") for (int k = 0; k < 2; ++k) \
        acc[ai][bj][m][n] = __builtin_amdgcn_mfma_f32_16x16x32_bf16(Bt[n][k], At[m][k], acc[ai][bj][m][n], 0, 0, 0); __builtin_amdgcn_s_setprio(0); } while (0)
#define PG8_WAIT_V(n) asm volatile("s_waitcnt vmcnt(" #n ")" ::: "memory")
#define PG8_WAIT_L(n) asm volatile("s_waitcnt lgkmcnt(" #n ")" ::: "memory")
#define PG8_BAR __builtin_amdgcn_s_barrier()
#define PG8_SCHED __builtin_amdgcn_sched_barrier(0)
#define PG8_SETV(v, u) do { _Pragma("unroll") for (int _h = 0; _h < 2; ++_h) _Pragma("unroll") for (int _i = 0; _i < 2; ++_i) { \
        if constexpr (GATHER) { const int _tok = S.gather_row(u, _h * HALF + stR[_i]); v[_h][_i] = (unsigned)(_tok * K + stC[_i]) * 2u; } \
        else v[_h][_i] = (unsigned)((_h * HALF + stR[_i]) * K + stC[_i]) * 2u; } } while (0)
#define PG8_STAGE_SEL(bufoff, gbase, h) do { _Pragma("unroll") for (int _i = 0; _i < 2; ++_i) { const unsigned _o = (GATHER && last) ? vN[h][_i] : vC[h][_i]; \
        __builtin_amdgcn_global_load_lds((const unsigned*)((const char*)(gbase) + _o), (PG8_LAS unsigned*)(lds + (bufoff) + ldsw + _i * 8192), 16, 0, 0); } } while (0)
    Unit cur, nxt; int ui = 0;
    if (!S.next(0, cur)) return;
    f32x4 acc[2][2][4][2];
#pragma unroll
    for (int a = 0; a < 2; ++a)
#pragma unroll
        for (int b = 0; b < 2; ++b)
#pragma unroll
            for (int m = 0; m < 4; ++m)
#pragma unroll
                for (int n = 0; n < 2; ++n) acc[a][b][m][n] = (f32x4){0.f, 0.f, 0.f, 0.f};
    bf16x8 At[4][2], B0[2][2], B1[2][2];
    PG8_SETV(vC, cur);
    if constexpr (GATHER) asm volatile("s_waitcnt vmcnt(0)" : "+v"(vC[0][0]), "+v"(vC[0][1]), "+v"(vC[1][0]), "+v"(vC[1][1]) :: "memory");
    const char* cA = GATHER ? (const char*)g.A : (const char*)g.A + (size_t)cur.pm * tstep; const char* cB = (const char*)g.Bt + (size_t)cur.pn * tstep;
    S.a_ready(cur);
    PG8_STAGE(PG8_SB(0, 0), cB, voffB); PG8_STAGE(PG8_SB(0, 1), cB + hstep, voffB); PG8_STAGE(PG8_SA(0, 0), cA, vC[0]); PG8_STAGE(PG8_SA(0, 1), cA, vC[1]);
    if (wr == 1) PG8_BAR;
    PG8_WAIT_V(2); PG8_BAR;
    PG8_STAGE(PG8_SB(1, 0), cB + kstep, voffB); PG8_STAGE(PG8_SA(1, 0), cA + kstep, vC[0]); PG8_STAGE(PG8_SB(1, 1), cB + hstep + kstep, voffB);
    PG8_WAIT_V(6); PG8_BAR;
    for (;;) {
        const bool has_next = S.next(ui + 1, nxt);
        if constexpr (GATHER) {
            if (has_next) { PG8_SETV(vN, nxt); asm volatile("s_waitcnt vmcnt(0)" : "+v"(vN[0][0]), "+v"(vN[0][1]), "+v"(vN[1][0]), "+v"(vN[1][1]) :: "memory"); }
            else {
#pragma unroll
                for (int h = 0; h < 2; ++h)
#pragma unroll
                    for (int i = 0; i < 2; ++i) vN[h][i] = vC[h][i]; }
        }
        const char* nA = GATHER ? cA : (has_next ? (const char*)g.A + (size_t)nxt.pm * tstep : cA); const char* nB = has_next ? (const char*)g.Bt + (size_t)nxt.pn * tstep : cB;
        for (int t = 0; t < nt; t += 2) {
            const bool last = (t == nt - 2);
            const char* a1 = cA + (size_t)(t + 1) * kstep;
            const char* a2 = last ? nA : cA + (size_t)(t + 2) * kstep; const char* b2 = last ? nB : cB + (size_t)(t + 2) * kstep;
            const char* a3 = a2 + kstep; const char* b3 = b2 + kstep;
            if (last && has_next) S.a_ready(nxt);
            PG8_LDB(B0, 0, 0); PG8_LDB(B1, 0, 1); PG8_SCHED; PG8_LDA(At, 0, 0); PG8_STAGE(PG8_SA(1, 1), a1, vC[1]);
            PG8_WAIT_V(8); PG8_WAIT_L(0); PG8_BAR; PG8_MMA(0, 0, At, B0); PG8_MMA(0, 1, At, B1); PG8_BAR; PG8_SCHED;
            PG8_LDA(At, 0, 1); PG8_STAGE(PG8_SB(0, 0), b2, voffB); PG8_STAGE(PG8_SB(0, 1), b2 + hstep, voffB); PG8_STAGE_SEL(PG8_SA(0, 0), a2, 0);
            PG8_WAIT_V(8); PG8_WAIT_L(0); PG8_BAR; PG8_MMA(1, 0, At, B0); PG8_MMA(1, 1, At, B1); PG8_BAR; PG8_SCHED;
            PG8_LDB(B0, 1, 0); PG8_LDB(B1, 1, 1); PG8_SCHED; PG8_LDA(At, 1, 0); PG8_STAGE_SEL(PG8_SA(0, 1), a2, 1);
            PG8_WAIT_V(8); PG8_WAIT_L(0); PG8_BAR; PG8_MMA(0, 0, At, B0); PG8_MMA(0, 1, At, B1); PG8_BAR; PG8_SCHED;
            PG8_LDA(At, 1, 1); PG8_STAGE(PG8_SB(1, 0), b3, voffB); PG8_STAGE(PG8_SB(1, 1), b3 + hstep, voffB); PG8_STAGE_SEL(PG8_SA(1, 0), a3, 0);
            PG8_WAIT_V(8); PG8_WAIT_L(0); PG8_BAR; PG8_MMA(1, 0, At, B0); PG8_MMA(1, 1, At, B1); PG8_BAR; PG8_SCHED;
        }
        if constexpr (ALIGN_EPI) { if (wr == 0) PG8_BAR; }
        E(acc, cur, wr, wc, fr, fq); S.done(cur);
        if (!has_next) break;
#pragma unroll
        for (int a = 0; a < 2; ++a)
#pragma unroll
            for (int b = 0; b < 2; ++b)
#pragma unroll
                for (int m = 0; m < 4; ++m)
#pragma unroll
                    for (int n = 0; n < 2; ++n) acc[a][b][m][n] = (f32x4){0.f, 0.f, 0.f, 0.f};
        cur = nxt; cA = nA; cB = nB; ++ui;
        if constexpr (GATHER) {
#pragma unroll
            for (int h = 0; h < 2; ++h)
#pragma unroll
                for (int i = 0; i < 2; ++i) vC[h][i] = vN[h][i]; }
        if constexpr (ALIGN_EPI) { if (wr == 1) PG8_BAR; }
    }
    PG8_WAIT_V(0);
    if constexpr (!ALIGN_EPI) { if (wr == 0) PG8_BAR; }
    PG8_BAR;
#undef PG8_SA
#undef PG8_SB
#undef PG8_STAGE
#undef PG8_LDA
#undef PG8_LDB
#undef PG8_MMA
#undef PG8_WAIT_V
#undef PG8_WAIT_L
#undef PG8_BAR
#undef PG8_SCHED
#undef PG8_SETV
#undef PG8_STAGE_SEL
}
}
#define GAS __attribute__((address_space(1)))
#define LAS __attribute__((address_space(3)))
typedef unsigned short bf16;
typedef unsigned v4u __attribute__((ext_vector_type(4)));
typedef float f32x4 __attribute__((ext_vector_type(4)));
typedef short bf16x8 __attribute__((ext_vector_type(8)));
typedef GAS unsigned gu32;
typedef GAS unsigned long long gu64;
#define RLX_AGENT __ATOMIC_RELAXED, __HIP_MEMORY_SCOPE_AGENT
#define LDS_WAIT() asm volatile("s_waitcnt lgkmcnt(0)" ::: "memory")
#define VM_WAIT() asm volatile("s_waitcnt vmcnt(0)" ::: "memory")
__device__ __forceinline__ unsigned long long rt() { return __builtin_amdgcn_s_memrealtime(); }
__device__ __forceinline__ unsigned f2bf(float f) { unsigned u = __builtin_bit_cast(unsigned, f); return (u + 0x7fffu + ((u >> 16) & 1u)) >> 16; }
__device__ __forceinline__ unsigned pk2(float lo, float hi) { return f2bf(lo) | (f2bf(hi) << 16); }

#define XB_TMO      128
#define XB_XCNT(j)  (256  + 64 * (j))
#define XB_XSUB(j)  (1280 + 64 * (j))
#define XB_XGEN(j)  (2304 + 64 * (j))
#define XB_TOP      3328
#define XB_TOPGEN   3392
#define XCD_BAR_WORDS 3456
#define XB_SPIN_CAP (1u << 18)

__device__ __forceinline__ unsigned xb_ld(unsigned* p)              { return __hip_atomic_load(p, __ATOMIC_RELAXED, __HIP_MEMORY_SCOPE_AGENT); }
__device__ __forceinline__ unsigned xb_add(unsigned* p, unsigned v) { return __hip_atomic_fetch_add(p, v, __ATOMIC_RELAXED, __HIP_MEMORY_SCOPE_AGENT); }
__device__ __forceinline__ unsigned xb_xcc_id() { return (unsigned)__builtin_amdgcn_s_getreg((3 << 11) | 20) & 0xFu; }
#define XB_SPIN(cond, bar) do { unsigned _sp = 0; while (cond) { __builtin_amdgcn_s_sleep(1); \
    if ((++_sp & 255u) == 0u) { if (xb_ld(&(bar)[XB_TMO])) break; if (_sp > XB_SPIN_CAP) { atomicAdd(&(bar)[XB_TMO], 1u); break; } } } } while (0)

struct XcdBarrier {
    unsigned* bar; unsigned x;
    volatile LAS unsigned* st;
};

__device__ __forceinline__ XcdBarrier xcd_barrier_post(unsigned* bar, volatile LAS unsigned* st) {
    XcdBarrier b; b.bar = bar; b.x = xb_xcc_id(); b.st = st;
    if (threadIdx.x == 0) (void)xb_add(&bar[XB_XCNT(b.x)], 1u);
    return b;
}
__device__ __forceinline__ void xcd_barrier_complete(unsigned* bar, unsigned x, unsigned& nloc, unsigned& nx) {
    const unsigned G = gridDim.x * gridDim.y * gridDim.z;
    unsigned sum, cnt, mine, sp = 0u;
    for (;;) {
        sum = 0u; cnt = 0u; mine = 0u;
#pragma unroll
        for (unsigned j = 0; j < 16; ++j) { const unsigned c = xb_ld(&bar[XB_XCNT(j)]); sum += c; cnt += (c > 0u) ? 1u : 0u; mine = (j == x) ? c : mine; }
        if (sum == G) break;
        __builtin_amdgcn_s_sleep(1);
        if ((++sp & 255u) == 0u) { if (xb_ld(&bar[XB_TMO])) break; if (sp > XB_SPIN_CAP) { atomicAdd(&bar[XB_TMO], 1u); break; } }
    }
    nloc = mine > 0u ? mine : 1u; nx = cnt > 0u ? cnt : 1u;
}

__device__ __forceinline__ void xcd_barrier(const XcdBarrier& b) {
    asm volatile("s_waitcnt vmcnt(0)" ::: "memory");
    __syncthreads();
    if (threadIdx.x == 0) {
        unsigned* bar = b.bar;
        __builtin_amdgcn_s_waitcnt(0);
        unsigned nloc = b.st[0], nx = b.st[1];
        if (nloc == 0u) { xcd_barrier_complete(bar, b.x, nloc, nx); b.st[0] = nloc; b.st[1] = nx; }
        const unsigned old = xb_add(&bar[XB_XSUB(b.x)], 1u);
        const unsigned gen = old / nloc;
        if (old + 1u == (gen + 1u) * nloc) {
            __builtin_amdgcn_fence(__ATOMIC_RELEASE, "agent");
            asm volatile("s_waitcnt vmcnt(0)" ::: "memory");
            const unsigned og = xb_add(&bar[XB_TOP], 1u);
            const unsigned tg = og / nx;
            if (og + 1u == (tg + 1u) * nx) xb_add(&bar[XB_TOPGEN], 1u);
            else XB_SPIN(xb_ld(&bar[XB_TOPGEN]) == tg, bar);
            __builtin_amdgcn_fence(__ATOMIC_ACQUIRE, "agent");
            xb_add(&bar[XB_XGEN(b.x)], 1u);
            asm volatile("s_waitcnt vmcnt(0)" ::: "memory");
        } else {
            XB_SPIN(xb_ld(&bar[XB_XGEN(b.x)]) == gen, bar);
            __builtin_amdgcn_fence(__ATOMIC_ACQUIRE, "agent");
            asm volatile("s_waitcnt vmcnt(0)" ::: "memory");
        }
    }
    __syncthreads();
}

constexpr int T = 16384, D = 1024, SEQ = 4096, NB = 4, INW = 5376, NL = 4;
constexpr int C_Q = 0, C_K = 1024, C_V = 1152, C_LX = 1280, C_LG = 2304, C_GA = 3328, C_GB = 4352;
constexpr int NE = 16, FF = 512;
constexpr float ALPHA = 1.681792830507429f;
constexpr float LN_EPS = 1e-5f;
constexpr float LOG2E = 1.4426950408889634f;
constexpr size_t MiB = 1u << 20;
constexpr size_t WS_CTL = 0, CTL_ZERO_BYTES = 1 * MiB;
constexpr int CW_TMO = 0, CW_BAR = 4096, CW_CNT = 16384;
constexpr size_t WS_MOD = 1 * MiB;
constexpr size_t WS_SUM = 2 * MiB;
constexpr size_t WS_EIDX = 3 * MiB;
constexpr size_t WS_EW = 3 * MiB + 512 * 1024;
constexpr size_t WS_LIST = 4 * MiB;
constexpr size_t WS_LRUW = 5 * MiB;
constexpr size_t WS_WIN = 6 * MiB;
constexpr size_t WS_WO = 17 * MiB;
constexpr size_t WS_WGU = 19 * MiB;
constexpr size_t WS_WD = 51 * MiB;
constexpr size_t WS_U = 68 * MiB;
constexpr size_t WS_P = 100 * MiB;
constexpr size_t WS_Y = 268 * MiB;
constexpr size_t WS_H = 300 * MiB;
constexpr size_t WS_END = 336 * MiB;
constexpr size_t WS_TA = 336 * MiB, WS_TI = 400 * MiB, WS_TZ = 464 * MiB, WS_END_HYB = 528 * MiB;

constexpr int NWAVES = 8;
constexpr int RING_OFF = 0, RING_BYTES = 131072;
constexpr int LDSCTL_OFF = RING_BYTES;
constexpr int LDS_BYTES = 147456;

typedef float f32x16 __attribute__((ext_vector_type(16)));
typedef unsigned u32x2 __attribute__((ext_vector_type(2)));
__device__ __forceinline__ float bf2f(unsigned v) { return __uint_as_float(v << 16); }
__device__ __forceinline__ float fast_sigmoid(float x) { return __builtin_amdgcn_rcpf(1.0f + __builtin_amdgcn_exp2f(-LOG2E * x)); }
__device__ __forceinline__ float gelu_tanh_f(float x) { const float u = 0.7978845608028654f * (x + 0.044715f * x * x * x); return x * fast_sigmoid(2.0f * u); }
__device__ __forceinline__ float wave_sum(float v) {
#pragma unroll
    for (int o = 1; o < 64; o <<= 1) v += __shfl_xor(v, o);
    return v;
}
__constant__ int c_bucket[128] = {0, 1, 2, 3, 4, 5, 6, 7, 8, 9, 10, 11, 12, 13, 14, 15, 16, 16, 16, 17, 17, 18, 18, 18, 19, 19, 19, 20, 20, 20, 20, 21, 21, 21, 21, 22, 22, 22, 22, 22, 23, 23, 23, 23, 23, 23, 24, 24, 24, 24, 24, 24, 25, 25, 25, 25, 25, 25, 25, 26, 26, 26, 26, 26, 26, 26, 26, 27, 27, 27, 27, 27, 27, 27, 27, 27, 27, 28, 28, 28, 28, 28, 28, 28, 28, 28, 28, 29, 29, 29, 29, 29, 29, 29, 29, 29, 29, 29, 29, 30, 30, 30, 30, 30, 30, 30, 30, 30, 30, 30, 30, 30, 30, 31, 31, 31, 31, 31, 31, 31, 31, 31, 31, 31, 31, 31, 31, 31};

struct Ptrs {
    const float *x, *c, *ada_w, *ada_b, *w_in, *attn_sink, *rel_bias, *conv_w, *conv_b, *lru_wa, *lru_ba, *lru_wx, *lru_bx, *lru_lambda, *w_out, *ln1_g, *ln1_b, *router_w, *router_b, *moe_wg, *moe_wu, *moe_wd, *ln2_g, *ln2_b;
    float* out; unsigned char* ws;
};

__device__ __forceinline__ void transpose_item(const float* W, int K, int N, bf16* WT, int row_off, LAS float* scr, int item, int lane) {
    const int nblk = N / 32, kb = item / nblk, nb = item % nblk, k0 = 64 * kb, n0 = 32 * nb;
#pragma unroll 8
    for (int i = 0; i < 32; ++i) { const int kk = 2 * i + (lane >> 5); scr[kk * 33 + (lane & 31)] = W[(size_t)(k0 + kk) * N + n0 + (lane & 31)]; }
    LDS_WAIT(); asm volatile("" ::: "memory");
    const int c = lane & 7;
#pragma unroll
    for (int j = 0; j < 4; ++j) { const int n = (lane >> 3) + 8 * j; const LAS float* s = scr + (8 * c) * 33 + n;
        v4u o; o.x = pk2(s[0 * 33], s[1 * 33]); o.y = pk2(s[2 * 33], s[3 * 33]); o.z = pk2(s[4 * 33], s[5 * 33]); o.w = pk2(s[6 * 33], s[7 * 33]);
        *(GAS v4u*)(WT + (size_t)(row_off + n0 + n) * K + k0 + 8 * c) = o; }
    LDS_WAIT(); asm volatile("" ::: "memory");
}
__device__ __forceinline__ void convert_layer(const Ptrs& p, int l, LAS unsigned char* lds, int gw, int NGW, int wave, int lane) {
    LAS float* scr = (LAS float*)(lds + RING_OFF + wave * 16384);
    constexpr int I_IN = (D / 64) * (INW / 32), I_O = (D / 64) * (D / 32), I_GU = 2 * NE * 256, I_D = NE * 256, I_L = 128;
    constexpr int NITEMS = I_IN + I_O + I_GU + I_D + I_L;
    bf16* WinT = (bf16*)(p.ws + WS_WIN); bf16* WoT = (bf16*)(p.ws + WS_WO); bf16* WguT = (bf16*)(p.ws + WS_WGU); bf16* WdT = (bf16*)(p.ws + WS_WD); bf16* waT = (bf16*)(p.ws + WS_LRUW); bf16* wxT = waT + 8 * 128 * 128;
    for (int it = gw; it < NITEMS; it += NGW) {
        int r = it;
        if (r < I_IN) { transpose_item(p.w_in + (size_t)l * D * INW, D, INW, WinT, 0, scr, r, lane); continue; } r -= I_IN;
        if (r < I_O) { transpose_item(p.w_out + (size_t)l * D * D, D, D, WoT, 0, scr, r, lane); continue; } r -= I_O;
        if (r < I_GU) { const int mat = r / (NE * 256); const int q = r % (NE * 256); const int e = q / 256, ti = q % 256; const int n0 = 32 * (ti % 16);
            const float* W = (mat ? p.moe_wu : p.moe_wg) + ((size_t)l * NE + e) * D * FF;
            transpose_item(W, D, FF, WguT, e * 1024 + (n0 / 128) * 256 + mat * 128 + (n0 % 128) - n0, scr, ti, lane); continue; } r -= I_GU;
        if (r < I_D) { const int e = r / 256, ti = r % 256; transpose_item(p.moe_wd + ((size_t)l * NE + e) * FF * D, FF, D, WdT, e * 1024, scr, ti, lane); continue; } r -= I_D;
        { const int mat = r / 64; const int q = r % 64; const int hb = q / 8, ti = q % 8;
            transpose_item((mat ? p.lru_wx : p.lru_wa) + ((size_t)l * 8 + hb) * 128 * 128, 128, 128, mat ? wxT : waT, hb * 128, scr, ti, lane); }
    }
}
__device__ __forceinline__ void mod_item(const Ptrs& p, int item, LAS unsigned char* lds, int tid, int wave, int lane) {
    LAS float* ca = (LAS float*)lds;
    LAS float* red = (LAS float*)(lds + 16384);
    const int l = item / 24, j0 = (item % 24) * 256;
    for (int i = tid; i < NB * D; i += 512) { const float v = p.c[i]; ca[i] = v * fast_sigmoid(v); }
    __syncthreads();
    f32x4 acc[NB];
#pragma unroll
    for (int b = 0; b < NB; ++b) acc[b] = (f32x4){0.f, 0.f, 0.f, 0.f};
    const float* w = p.ada_w + (size_t)l * D * 6144 + j0 + 4 * lane;
#pragma unroll 8
    for (int kk = 0; kk < 128; ++kk) { const int k = wave * 128 + kk; const f32x4 wv = *(const f32x4*)(w + (size_t)k * 6144);
#pragma unroll
        for (int b = 0; b < NB; ++b) acc[b] += wv * ca[b * D + k]; }
#pragma unroll
    for (int b = 0; b < NB; ++b) *(LAS f32x4*)(red + (wave * NB + b) * 256 + 4 * lane) = acc[b];
    __syncthreads();
    float* mod = (float*)(p.ws + WS_MOD);
    for (int i = tid; i < NB * 256; i += 512) { const int b = i / 256, jj = i % 256; float s = 0.f;
#pragma unroll
        for (int w8 = 0; w8 < 8; ++w8) s += red[(w8 * NB + b) * 256 + jj];
        mod[((size_t)l * NB + b) * 6144 + j0 + jj] = s + p.ada_b[l * 6144 + j0 + jj]; }
    __syncthreads();
}
__device__ __forceinline__ void modulate_rows(const float* x, const float* mod_l, bf16* U, int gw, int NGW, int lane) {
    for (int row = gw; row < T; row += NGW) { const float* m = mod_l + (size_t)(row / SEQ) * 6144;
#pragma unroll
        for (int j = 0; j < 4; ++j) { const int col = 4 * lane + 256 * j; const f32x4 xv = *(const f32x4*)(x + (size_t)row * D + col), sh = *(const f32x4*)(m + col), sc = *(const f32x4*)(m + 1024 + col);
            const f32x4 u = xv * (sc + 1.0f) + sh; u32x2 o; o.x = pk2(u[0], u[1]); o.y = pk2(u[2], u[3]); *(u32x2*)(U + (size_t)row * D + col) = o; } }
}

constexpr int KS_STRIDE = 144;
constexpr int VT_STRIDE = 520;
constexpr int XC_STRIDE = 272;
constexpr int LB_K = 0, LB_V = 256 * KS_STRIDE  , LB_TBL = LB_V + 64 * VT_STRIDE  , LB_XC = LB_TBL + 8 * 192 * 4  , LB_END = LB_XC + 4 * 32 * XC_STRIDE  ;
static_assert(LB_END <= RING_BYTES, "phase B LDS");

template <bool FINAL>
__device__ __forceinline__ void phase_b(const Ptrs& p, int l, LAS unsigned char* lds, int vcu, int G) {
    const bf16* P = (const bf16*)(p.ws + WS_P); bf16* Y = (bf16*)(p.ws + WS_Y);
    float* SA = (float*)(p.ws + WS_SUM); float* SB = SA + NB * 32 * 1024;
    const bf16* waT = (const bf16*)(p.ws + WS_LRUW); const bf16* wxT = waT + 8 * 128 * 128;
    for (int unit = vcu; unit < 256; unit += G) {
        int tid = threadIdx.x; asm volatile("" : "+v"(tid));
        const int lane = tid & 63, w = __builtin_amdgcn_readfirstlane(tid >> 6), l31 = lane & 31, hi = lane >> 5;
        const int b = unit >> 6, n = (unit & 63) >> 1, half = unit & 1;
        const int row0 = b * SEQ + n * 128;
        __syncthreads();
        if (FINAL) {
#pragma unroll
            for (int it = 0; it < 4; ++it) { const int idx = it * 512 + tid, r = idx >> 3, ch = idx & 7;
                v4u v = (v4u){0u, 0u, 0u, 0u};
                if (n > 0 || r >= 128) v = *(const v4u*)(P + (size_t)(row0 - 128 + r) * INW + C_K + half * 64 + ch * 8);
                *(LAS v4u*)(lds + LB_K + r * KS_STRIDE + ch * 16) = v; }
            { const int kg = tid >> 3, dc = tid & 7; v4u v[4];
#pragma unroll
                for (int i = 0; i < 4; ++i) { const int r = 4 * kg + i; v[i] = (v4u){0u, 0u, 0u, 0u};
                    if (n > 0 || r >= 128) v[i] = *(const v4u*)(P + (size_t)(row0 - 128 + r) * INW + C_V + half * 64 + dc * 8); }
#pragma unroll
                for (int d2 = 0; d2 < 4; ++d2) {
                    const unsigned a0 = v[0][d2], a1 = v[1][d2], a2 = v[2][d2], a3 = v[3][d2];
                    u32x2 lo, hh; lo.x = (a0 & 0xffffu) | (a1 << 16); lo.y = (a2 & 0xffffu) | (a3 << 16); hh.x = (a0 >> 16) | (a1 & 0xffff0000u); hh.y = (a2 >> 16) | (a3 & 0xffff0000u);
                    *(LAS u32x2*)(lds + LB_V + (dc * 8 + 2 * d2) * VT_STRIDE + kg * 8) = lo; *(LAS u32x2*)(lds + LB_V + (dc * 8 + 2 * d2 + 1) * VT_STRIDE + kg * 8) = hh; } }
#pragma unroll
            for (int i = 0; i < 3; ++i) { const int idx = tid + 512 * i, hd = idx / 192, xi = idx % 192, xx = xi - 32;
                float v = -INFINITY; if (xx >= 0 && xx < 128) v = p.rel_bias[c_bucket[127 - xx] * 16 + half * 8 + hd] * LOG2E;
                ((LAS float*)(lds + LB_TBL))[idx] = v; }
        }
        const int chT = half * 512 + tid;
        float xm3 = 0.f, xm2 = 0.f, xm1 = 0.f;
        if (n > 0) { xm3 = bf2f(P[(size_t)(row0 - 3) * INW + C_LX + chT]); xm2 = bf2f(P[(size_t)(row0 - 2) * INW + C_LX + chT]); xm1 = bf2f(P[(size_t)(row0 - 1) * INW + C_LX + chT]); }
        const int hbl = w >> 1, jb = (w & 1) * 64;
        const int hb = half * 4 + hbl;
        float hprev[2], atot[2];
#pragma unroll
        for (int dh = 0; dh < 2; ++dh) { const int ch = hb * 128 + jb + dh * 32 + l31;
            hprev[dh] = 0.f; atot[dh] = 1.f;
            if (FINAL) { float h = 0.f; for (int q = 0; q < n; ++q) { const size_t o = ((size_t)b * 32 + q) * 1024 + ch; h = SA[o] * h + SB[o]; } hprev[dh] = h; } }
        const float sink2 = FINAL ? p.attn_sink[l * 16 + half * 8 + w] * LOG2E : 0.f;
#pragma unroll 1
        for (int c = 0; c < 4; ++c) {
            __syncthreads();
            { LAS unsigned short* xcs = (LAS unsigned short*)(lds + LB_XC + (tid >> 7) * (32 * XC_STRIDE)) + (tid & 127);
                const bf16* src = P + (size_t)(row0 + 32 * c) * INW + C_LX + chT;
                const float cw0 = p.conv_w[((size_t)l * 4 + 0) * D + chT], cw1 = p.conv_w[((size_t)l * 4 + 1) * D + chT], cw2 = p.conv_w[((size_t)l * 4 + 2) * D + chT], cw3 = p.conv_w[((size_t)l * 4 + 3) * D + chT], cbv = p.conv_b[l * D + chT];
#pragma unroll 8
                for (int tt = 0; tt < 32; ++tt) { const float xv = bf2f(src[(size_t)tt * INW]); const float xc = cbv + cw0 * xm3 + cw1 * xm2 + cw2 * xm1 + cw3 * xv;
                    xcs[tt * (XC_STRIDE / 2)] = (unsigned short)f2bf(xc); xm3 = xm2; xm2 = xm1; xm1 = xv; } }
            __syncthreads();
            f32x16 O[2];
            if (FINAL) {
                const int hq = half * 8 + w;
                bf16x8 qr[4];
#pragma unroll
                for (int ks = 0; ks < 4; ++ks) qr[ks] = *(const bf16x8*)(P + (size_t)(row0 + 32 * c + l31) * INW + C_Q + hq * 64 + 16 * ks + 8 * hi);
                f32x16 st[5];
#pragma unroll
                for (int jj = 0; jj < 5; ++jj) { st[jj] = (f32x16){};
#pragma unroll
                    for (int ks = 0; ks < 4; ++ks) { const bf16x8 kf = *(const LAS bf16x8*)(lds + LB_K + (32 * (c + jj) + l31) * KS_STRIDE + (16 * ks + 8 * hi) * 2);
                        st[jj] = __builtin_amdgcn_mfma_f32_32x32x16_bf16(kf, qr[ks], st[jj], 0, 0, 0); } }
                const LAS float* tb = (const LAS float*)(lds + LB_TBL) + w * 192 + (31 - l31 + 4 * hi);
                float m = sink2;
#pragma unroll
                for (int jj = 0; jj < 5; ++jj) { const bool dead = (n == 0) && (c + jj < 4);
#pragma unroll
                    for (int r = 0; r < 16; ++r) { float v = st[jj][r] * (0.125f * LOG2E) + tb[32 * jj + (r & 3) + 8 * (r >> 2)]; if (dead) v = -INFINITY; st[jj][r] = v; m = fmaxf(m, v); } }
                m = fmaxf(m, __shfl_xor(m, 32));
                float sum = 0.f;
#pragma unroll
                for (int jj = 0; jj < 5; ++jj)
#pragma unroll
                    for (int r = 0; r < 16; ++r) { const float e = __builtin_amdgcn_exp2f(st[jj][r] - m); st[jj][r] = e; sum += e; }
                sum += __shfl_xor(sum, 32);
                const float inv = __builtin_amdgcn_rcpf(sum + __builtin_amdgcn_exp2f(sink2 - m));
                O[0] = (f32x16){}; O[1] = (f32x16){};
#pragma unroll
                for (int jj = 0; jj < 5; ++jj)
#pragma unroll
                    for (int s2 = 0; s2 < 2; ++s2) {
                        v4u pw; pw.x = pk2(st[jj][8 * s2 + 0] * inv, st[jj][8 * s2 + 1] * inv); pw.y = pk2(st[jj][8 * s2 + 2] * inv, st[jj][8 * s2 + 3] * inv);
                        pw.z = pk2(st[jj][8 * s2 + 4] * inv, st[jj][8 * s2 + 5] * inv); pw.w = pk2(st[jj][8 * s2 + 6] * inv, st[jj][8 * s2 + 7] * inv);
                        const bf16x8 pa = __builtin_bit_cast(bf16x8, pw);
                        const int key0 = 32 * (c + jj) + 16 * s2 + 4 * hi;
#pragma unroll
                        for (int dh = 0; dh < 2; ++dh) { const LAS unsigned char* vp = lds + LB_V + (dh * 32 + l31) * VT_STRIDE + key0 * 2;
                            const u32x2 lo = *(const LAS u32x2*)vp, h2 = *(const LAS u32x2*)(vp + 16);
                            v4u vw; vw.x = lo.x; vw.y = lo.y; vw.z = h2.x; vw.w = h2.y;
                            O[dh] = __builtin_amdgcn_mfma_f32_32x32x16_bf16(pa, __builtin_bit_cast(bf16x8, vw), O[dh], 0, 0, 0); } }
            }
#pragma unroll
            for (int dh = 0; dh < 2; ++dh) {
                const int jcol = jb + dh * 32 + l31;
                const float ba_v = p.lru_ba[l * D + hb * 128 + jcol], bx_v = p.lru_bx[l * D + hb * 128 + jcol];
                const float kk_v = -8.0f * log1pf(__expf(-p.lru_lambda[l * D + hb * 128 + jcol]));
                f32x16 ra = (f32x16){}, ia = (f32x16){};
                const bf16* wap = waT + ((size_t)hb * 128 + jcol) * 128 + 8 * hi; const bf16* wxp = wxT + ((size_t)hb * 128 + jcol) * 128 + 8 * hi;
#pragma unroll
                for (int ks = 0; ks < 8; ++ks) { const bf16x8 af = *(const LAS bf16x8*)(lds + LB_XC + hbl * (32 * XC_STRIDE) + l31 * XC_STRIDE + (16 * ks + 8 * hi) * 2);
                    const bf16x8 bwa = *(const bf16x8*)(wap + 16 * ks), bwx = *(const bf16x8*)(wxp + 16 * ks);
                    ra = __builtin_amdgcn_mfma_f32_32x32x16_bf16(af, bwa, ra, 0, 0, 0); ia = __builtin_amdgcn_mfma_f32_32x32x16_bf16(af, bwx, ia, 0, 0, 0); }
                float av[16], bv[16];
                const LAS unsigned short* xcol = (const LAS unsigned short*)(lds + LB_XC + hbl * (32 * XC_STRIDE)) + jcol;
#pragma unroll
                for (int r = 0; r < 16; ++r) { const int tok = (r & 3) + 8 * (r >> 2) + 4 * hi;
                    const float rr = fast_sigmoid(ra[r] + ba_v), ii = fast_sigmoid(ia[r] + bx_v);
                    const float la = kk_v * rr;
                    const float a = __builtin_amdgcn_exp2f(la * LOG2E);
                    const float e2 = 2.0f * la;
                    const float om = (e2 > -0.1f) ? -e2 * (1.0f + e2 * (0.5f + e2 * (0.16666667f + e2 * 0.041666668f))) : 1.0f - a * a;
                    const float xc = bf2f(xcol[tok * (XC_STRIDE / 2)]);
                    av[r] = a; bv[r] = __builtin_sqrtf(om) * (ii * xc); }
                float Ag[4], Bg[4], Ap[4], Bp[4];
#pragma unroll
                for (int g = 0; g < 4; ++g) { float A = av[4 * g], B = bv[4 * g];
#pragma unroll
                    for (int e = 1; e < 4; ++e) { B = av[4 * g + e] * B + bv[4 * g + e]; A *= av[4 * g + e]; }
                    Ag[g] = A; Bg[g] = B; Ap[g] = __shfl_xor(A, 32); Bp[g] = __shfl_xor(B, 32); }
                float hs = hprev[dh], At = atot[dh], stt[4];
#pragma unroll
                for (int g = 0; g < 4; ++g) { const float A0 = hi ? Ap[g] : Ag[g], B0 = hi ? Bp[g] : Bg[g], A1 = hi ? Ag[g] : Ap[g], B1 = hi ? Bg[g] : Bp[g];
                    const float s0 = hs; hs = A0 * hs + B0; const float s1 = hs; hs = A1 * hs + B1; stt[g] = hi ? s1 : s0; At *= A0 * A1; }
                hprev[dh] = hs; atot[dh] = At;
                if (FINAL) {
                    const int col = hb * 128 + jcol;
#pragma unroll
                    for (int g = 0; g < 4; ++g) { float h = stt[g];
#pragma unroll
                        for (int e = 0; e < 4; ++e) { const int r = 4 * g + e; h = av[r] * h + bv[r];
                            const size_t trow = (size_t)(row0 + 32 * c + (r & 3) + 8 * (r >> 2) + 4 * hi);
                            const bf16* pr = P + trow * INW + col;
                            const float ga = bf2f(pr[C_GA]), gb = bf2f(pr[C_GB]), lg = bf2f(pr[C_LG]);
                            const float y = fast_sigmoid(ga) * O[dh][r] + fast_sigmoid(gb) * gelu_tanh_f(lg) * h;
                            Y[trow * D + col] = (bf16)f2bf(y); } }
                }
            }
        }
        if (!FINAL) {
#pragma unroll
            for (int dh = 0; dh < 2; ++dh) if (hi == 0) { const size_t o = ((size_t)b * 32 + n) * 1024 + hb * 128 + jb + dh * 32 + l31; SA[o] = atot[dh]; SB[o] = hprev[dh]; }
        }
    }
}

__device__ __forceinline__ void phase_ln1(const Ptrs& p, int l, LAS unsigned char* lds, int gw, int NGW, int tid, int lane) {
    LAS float* rwT = (LAS float*)lds;
    for (int i = tid; i < D * NE; i += 512) rwT[(i & 15) * D + (i >> 4)] = p.router_w[i];
    __syncthreads();
    const float* xin = (l == 0) ? p.x : p.out; float* xout = p.out;
    const bf16* Z = (const bf16*)(p.ws + WS_H); bf16* U = (bf16*)(p.ws + WS_U);
    const float* mod_l = (const float*)(p.ws + WS_MOD) + (size_t)l * NB * 6144;
    int* eidx = (int*)(p.ws + WS_EIDX); float* ew = (float*)(p.ws + WS_EW); int* list = (int*)(p.ws + WS_LIST);
    unsigned* cnt = (unsigned*)(p.ws + WS_CTL) + CW_CNT + l * 16;
    const float* g = p.ln1_g + l * D; const float* bt = p.ln1_b + l * D;
    for (int row = gw; row < T; row += NGW) {
        const float* m = mod_l + (size_t)(row / SEQ) * 6144;
        f32x4 v[4]; float s = 0.f;
#pragma unroll
        for (int j = 0; j < 4; ++j) { const int col = 4 * lane + 256 * j; const f32x4 xv = *(const f32x4*)(xin + (size_t)row * D + col), g1 = *(const f32x4*)(m + 2048 + col);
            const u32x2 zz = *(const u32x2*)(Z + (size_t)row * D + col);
            const f32x4 zf = (f32x4){bf2f(zz.x & 0xffffu), bf2f(zz.x >> 16), bf2f(zz.y & 0xffffu), bf2f(zz.y >> 16)};
            v[j] = xv * ALPHA + g1 * zf; s += (v[j][0] + v[j][1]) + (v[j][2] + v[j][3]); }
        const float mean = wave_sum(s) * (1.f / D); float q = 0.f;
#pragma unroll
        for (int j = 0; j < 4; ++j) { v[j] = v[j] - mean; q += (v[j][0] * v[j][0] + v[j][1] * v[j][1]) + (v[j][2] * v[j][2] + v[j][3] * v[j][3]); }
        const float rstd = 1.0f / sqrtf(wave_sum(q) * (1.f / D) + LN_EPS);
        float lg[16];
#pragma unroll
        for (int e = 0; e < 16; ++e) lg[e] = 0.f;
#pragma unroll
        for (int j = 0; j < 4; ++j) { const int col = 4 * lane + 256 * j; const f32x4 gm = *(const f32x4*)(g + col), be = *(const f32x4*)(bt + col);
            const f32x4 xn = v[j] * rstd * gm + be; *(f32x4*)(xout + (size_t)row * D + col) = xn;
            const f32x4 sc = *(const f32x4*)(m + 4096 + col), sh = *(const f32x4*)(m + 3072 + col); const f32x4 uu = xn * (sc + 1.0f) + sh;
            u32x2 o; o.x = pk2(uu[0], uu[1]); o.y = pk2(uu[2], uu[3]); *(u32x2*)(U + (size_t)row * D + col) = o;
#pragma unroll
            for (int e = 0; e < 16; ++e) { const f32x4 rw = *(const LAS f32x4*)(rwT + e * D + col); lg[e] += (uu[0] * rw[0] + uu[1] * rw[1]) + (uu[2] * rw[2] + uu[3] * rw[3]); }
            asm volatile("" ::: "memory"); }
#pragma unroll
        for (int e = 0; e < 16; ++e) lg[e] = wave_sum(lg[e]);
        float sc[16]; float mx = -INFINITY;
#pragma unroll
        for (int e = 0; e < 16; ++e) { sc[e] = lg[e] + p.router_b[e]; mx = fmaxf(mx, sc[e]); }
        float sum = 0.f;
#pragma unroll
        for (int e = 0; e < 16; ++e) { sc[e] = __expf(sc[e] - mx); sum += sc[e]; }
        const float isum = 1.0f / sum;
#pragma unroll
        for (int e = 0; e < 16; ++e) sc[e] *= isum;
        int gsel = 0, bi0 = 0, bi1 = 1; float best = -1.f, bw0 = 0.f, bw1 = 0.f;
#pragma unroll
        for (int gI = 0; gI < 4; ++gI) {
            int i0 = 0; float w0 = sc[gI * 4];
#pragma unroll
            for (int k = 1; k < 4; ++k) if (sc[gI * 4 + k] > w0) { w0 = sc[gI * 4 + k]; i0 = k; }
            int i1 = -1; float w1 = -1.f;
#pragma unroll
            for (int k = 0; k < 4; ++k) if (k != i0 && sc[gI * 4 + k] > w1) { w1 = sc[gI * 4 + k]; i1 = k; }
            const float gs = w0 + w1;
            if (gs > best) { best = gs; gsel = gI; bi0 = i0; bi1 = i1; bw0 = w0; bw1 = w1; }
        }
        if (lane == 0) {
            const float wsum = bw0 + bw1; const int e0 = gsel * 4 + bi0, e1 = gsel * 4 + bi1;
            eidx[row * 2 + 0] = e0; eidx[row * 2 + 1] = e1; ew[row * 2 + 0] = bw0 / wsum; ew[row * 2 + 1] = bw1 / wsum;
            const unsigned p0 = __hip_atomic_fetch_add(cnt + e0, 1u, __ATOMIC_RELAXED, __HIP_MEMORY_SCOPE_AGENT); list[e0 * 16384 + p0] = row * 2 + 0;
            const unsigned p1 = __hip_atomic_fetch_add(cnt + e1, 1u, __ATOMIC_RELAXED, __HIP_MEMORY_SCOPE_AGENT); list[e1 * 16384 + p1] = row * 2 + 1;
        }
    }
}
__device__ __forceinline__ void phase_ln2(const Ptrs& p, int l, int gw, int NGW, int lane) {
    float* x = p.out; const bf16* F0 = (const bf16*)(p.ws + WS_P); const bf16* F1 = F0 + (size_t)T * D; bf16* U = (bf16*)(p.ws + WS_U);
    const float* mod_l = (const float*)(p.ws + WS_MOD) + (size_t)l * NB * 6144; const float* mod_n = mod_l + NB * 6144;
    const float* ew = (const float*)(p.ws + WS_EW);
    const float* g = p.ln2_g + l * D; const float* bt = p.ln2_b + l * D;
    for (int row = gw; row < T; row += NGW) {
        const float* m = mod_l + (size_t)(row / SEQ) * 6144; const float* mn = mod_n + (size_t)(row / SEQ) * 6144;
        const float wv = ew[row * 2 + (lane & 1)]; const float w0 = __shfl(wv, 0), w1 = __shfl(wv, 1);
        f32x4 v[4]; float s = 0.f;
#pragma unroll
        for (int j = 0; j < 4; ++j) { const int col = 4 * lane + 256 * j; const f32x4 xv = *(const f32x4*)(x + (size_t)row * D + col), g2 = *(const f32x4*)(m + 5120 + col);
            const u32x2 a = *(const u32x2*)(F0 + (size_t)row * D + col), c2 = *(const u32x2*)(F1 + (size_t)row * D + col);
            const f32x4 f = (f32x4){bf2f(a.x & 0xffffu), bf2f(a.x >> 16), bf2f(a.y & 0xffffu), bf2f(a.y >> 16)} * w0 + (f32x4){bf2f(c2.x & 0xffffu), bf2f(c2.x >> 16), bf2f(c2.y & 0xffffu), bf2f(c2.y >> 16)} * w1;
            v[j] = xv * ALPHA + g2 * f; s += (v[j][0] + v[j][1]) + (v[j][2] + v[j][3]); }
        const float mean = wave_sum(s) * (1.f / D); float q = 0.f;
#pragma unroll
        for (int j = 0; j < 4; ++j) { v[j] = v[j] - mean; q += (v[j][0] * v[j][0] + v[j][1] * v[j][1]) + (v[j][2] * v[j][2] + v[j][3] * v[j][3]); }
        const float rstd = 1.0f / sqrtf(wave_sum(q) * (1.f / D) + LN_EPS);
#pragma unroll
        for (int j = 0; j < 4; ++j) { const int col = 4 * lane + 256 * j; const f32x4 gm = *(const f32x4*)(g + col), be = *(const f32x4*)(bt + col);
            const f32x4 xn = v[j] * rstd * gm + be; *(f32x4*)(x + (size_t)row * D + col) = xn;
            if (l + 1 < NL) { const f32x4 sh = *(const f32x4*)(mn + col), sc = *(const f32x4*)(mn + 1024 + col); const f32x4 uu = xn * (sc + 1.0f) + sh;
                u32x2 o; o.x = pk2(uu[0], uu[1]); o.y = pk2(uu[2], uu[3]); *(u32x2*)(U + (size_t)row * D + col) = o; } }
    }
}
constexpr int N_PHASES = 2 + 8 * NL;
struct Args { const float* in[24]; float* out; unsigned char* ws; int ph_lo, ph_hi; };
__global__ void __launch_bounds__(NWAVES * 64, 2) fwd(Args args) {
    extern __shared__ __attribute__((aligned(16))) unsigned char lds_raw[];
    LAS unsigned char* lds = (LAS unsigned char*)lds_raw;
    const int tid = threadIdx.x, lane = tid & 63, wave = __builtin_amdgcn_readfirstlane(tid >> 6);
    const int G = gridDim.x, bx = blockIdx.x, vcu = (G % 8 == 0) ? (bx % 8) * (G / 8) + bx / 8 : bx;
    const int gw = vcu * NWAVES + wave, NGW = G * NWAVES;
    Ptrs p;
    p.x = args.in[0]; p.c = args.in[1]; p.ada_w = args.in[2]; p.ada_b = args.in[3]; p.w_in = args.in[4]; p.attn_sink = args.in[5]; p.rel_bias = args.in[6]; p.conv_w = args.in[7]; p.conv_b = args.in[8];
    p.lru_wa = args.in[9]; p.lru_ba = args.in[10]; p.lru_wx = args.in[11]; p.lru_bx = args.in[12]; p.lru_lambda = args.in[13]; p.w_out = args.in[14]; p.ln1_g = args.in[15]; p.ln1_b = args.in[16];
    p.router_w = args.in[17]; p.router_b = args.in[18]; p.moe_wg = args.in[19]; p.moe_wu = args.in[20]; p.moe_wd = args.in[21]; p.ln2_g = args.in[22]; p.ln2_b = args.in[23];
    p.out = args.out; p.ws = args.ws;
    LAS unsigned* ctlw = (LAS unsigned*)(lds + LDSCTL_OFF);
    for (int u = tid; u < 256; u += NWAVES * 64) ctlw[u] = 0u;
    __syncthreads();
    const int lo = args.ph_lo, hi = args.ph_hi;
    XcdBarrier bar; bar.bar = (unsigned*)(p.ws + WS_CTL) + CW_BAR; bar.x = 0; bar.st = nullptr;
    if (hi - lo > 1) bar = xcd_barrier_post((unsigned*)(p.ws + WS_CTL) + CW_BAR, (volatile LAS unsigned*)(ctlw + 16));
#define IN(k) (lo <= (k) && (k) < hi)
#define LAUNDER_TID() int tidp = threadIdx.x; asm volatile("" : "+v"(tidp)); const int lanep = tidp & 63, wavep = __builtin_amdgcn_readfirstlane(tidp >> 6), gwp = vcu * NWAVES + wavep; (void)lanep; (void)gwp
#define SEAM(k) do { if (IN(k) && IN((k) + 1)) xcd_barrier(bar); } while (0)
    bf16* U = (bf16*)(p.ws + WS_U); bf16* Pb = (bf16*)(p.ws + WS_P); bf16* Yb = (bf16*)(p.ws + WS_Y); bf16* Hb = (bf16*)(p.ws + WS_H);
    const float* mod = (const float*)(p.ws + WS_MOD);

    if (IN(0)) { LAUNDER_TID(); if (bx < NL * 24) mod_item(p, bx, lds, tidp, wavep, lanep); convert_layer(p, 0, lds, gwp, NGW, wavep, lanep); }
    SEAM(0);
    if (IN(1)) { LAUNDER_TID(); modulate_rows(p.x, mod, U, gwp, NGW, lanep); }
    SEAM(1);
#pragma unroll 1
    for (int l = 0; l < NL; ++l) {
        const int pb = 2 + 8 * l;
        if (IN(pb + 0)) { LAUNDER_TID(); pg8::Gemm g{U, (const bf16*)(p.ws + WS_WIN), T, INW, D}; pg8::StaticOrder S; S.init(T, INW, G, bx); pg8::EpiStoreBf16 E{Pb, INW};
            pg8::gemm_phase<pg8::EpiStoreBf16, pg8::StaticOrder, true, false>(lds + RING_OFF, g, S, E, tidp); }
        SEAM(pb + 0);
        if (IN(pb + 1)) phase_b<false>(p, l, lds, vcu, G);
        SEAM(pb + 1);
        if (IN(pb + 2)) phase_b<true>(p, l, lds, vcu, G);
        SEAM(pb + 2);
        if (IN(pb + 3)) { LAUNDER_TID(); pg8::Gemm g{Yb, (const bf16*)(p.ws + WS_WO), T, D, D}; pg8::StaticOrder S; S.init(T, D, G, bx); pg8::EpiStoreBf16 E{Hb, D};
            pg8::gemm_phase<pg8::EpiStoreBf16, pg8::StaticOrder, false, false>(lds + RING_OFF, g, S, E, tidp); }
        SEAM(pb + 3);
        if (IN(pb + 4)) { LAUNDER_TID(); phase_ln1(p, l, lds, gwp, NGW, tidp, lanep); }
        SEAM(pb + 4);
        if (IN(pb + 5)) { LAUNDER_TID();
            if (tidp < 16) ((LAS int*)ctlw)[tidp] = (int)__hip_atomic_load((unsigned*)(p.ws + WS_CTL) + CW_CNT + l * 16 + tidp, __ATOMIC_RELAXED, __HIP_MEMORY_SCOPE_AGENT);
            __syncthreads();
            pg8::Gemm g{U, (const bf16*)(p.ws + WS_WGU), T, NE * 1024, D}; pg8::MoeOrder S{(const LAS int*)ctlw, (const int*)(p.ws + WS_LIST), G, vcu}; pg8::EpiMoeGU E{Hb};
            pg8::gemm_phase<pg8::EpiMoeGU, pg8::MoeOrder, true, true>(lds + RING_OFF, g, S, E, tidp); }
        SEAM(pb + 5);
        if (IN(pb + 6)) { LAUNDER_TID();
            if (tidp < 16) ((LAS int*)ctlw)[tidp] = (int)__hip_atomic_load((unsigned*)(p.ws + WS_CTL) + CW_CNT + l * 16 + tidp, __ATOMIC_RELAXED, __HIP_MEMORY_SCOPE_AGENT);
            __syncthreads();
            pg8::Gemm g{Hb, (const bf16*)(p.ws + WS_WD), 36864, NE * 1024, FF}; pg8::MoeOrder S{(const LAS int*)ctlw, (const int*)(p.ws + WS_LIST), G, vcu}; pg8::EpiMoeDown E{Pb, (const int*)(p.ws + WS_LIST), T};
            pg8::gemm_phase<pg8::EpiMoeDown, pg8::MoeOrder, true, false>(lds + RING_OFF, g, S, E, tidp); }
        SEAM(pb + 6);
        if (IN(pb + 7)) { LAUNDER_TID(); phase_ln2(p, l, gwp, NGW, lanep); if (l + 1 < NL) convert_layer(p, l + 1, lds, gwp, NGW, wavep, lanep); }
        SEAM(pb + 7);
    }
#undef IN
#undef SEAM
}
#ifndef MK_SPLIT
#define MK_SPLIT 0
#endif
extern "C" void kernel_launch(void* const* d_in, const int* in_sizes, int n_in, void* d_out, int out_size, void* d_ws, size_t ws_size, hipStream_t stream) {
    static int grid = 0;
    if (grid == 0) {
        if (n_in != 24 || in_sizes[0] != T * D || out_size != T * D || ws_size < WS_END) { fprintf(stderr, "kernel_launch: unexpected shapes (n_in %d, in0 %d, out %d, ws %zu); nothing launched\n", n_in, n_in > 0 ? in_sizes[0] : -1, out_size, ws_size); grid = -1; return; }
        int dev = 0, cus = 0, per_cu = 0;
        if (hipGetDevice(&dev) != hipSuccess || hipDeviceGetAttribute(&cus, hipDeviceAttributeMultiprocessorCount, dev) != hipSuccess) { fprintf(stderr, "kernel_launch: device query failed\n"); grid = -1; return; }
        if (hipFuncSetAttribute((const void*)fwd, hipFuncAttributeMaxDynamicSharedMemorySize, LDS_BYTES) != hipSuccess) { fprintf(stderr, "kernel_launch: hipFuncSetAttribute failed\n"); grid = -1; return; }
        if (hipOccupancyMaxActiveBlocksPerMultiprocessor(&per_cu, (const void*)fwd, NWAVES * 64, LDS_BYTES) != hipSuccess || per_cu < 1) fprintf(stderr, "kernel_launch: occupancy query reports %d blocks per CU\n", per_cu);
        (void)hipGetLastError();
        grid = cus;
    }
    if (grid < 0) return;
    if (hipMemsetAsync((char*)d_ws + WS_CTL, 0, CTL_ZERO_BYTES, stream) != hipSuccess) { fprintf(stderr, "kernel_launch: memset failed\n"); return; }
    Args a{};
    for (int i = 0; i < 24; ++i) a.in[i] = (const float*)d_in[i];
    a.out = (float*)d_out; a.ws = (unsigned char*)d_ws;
#if MK_SPLIT
    for (int ph = 0; ph < N_PHASES; ++ph) { a.ph_lo = ph; a.ph_hi = ph + 1; hipLaunchKernelGGL(fwd, dim3(grid), dim3(NWAVES * 64), LDS_BYTES, stream, a); }
#else
    a.ph_lo = 0; a.ph_hi = N_PHASES; hipLaunchKernelGGL(fwd, dim3(grid), dim3(NWAVES * 64), LDS_BYTES, stream, a);
#endif
    const hipError_t le = hipPeekAtLastError();
    if (le != hipSuccess) fprintf(stderr, "kernel_launch: launch failed: %s\n", hipGetErrorName(le));
}
```

```cpp
#include <hip/hip_runtime.h>
#include <cstdio>
#include <cstdint>
#define MK_SPLIT 0
namespace pg8 {
#define PG8_LAS __attribute__((address_space(3)))
typedef unsigned short bf16_t;
typedef short bf16x8 __attribute__((ext_vector_type(8)));
typedef float f32x4 __attribute__((ext_vector_type(4)));
typedef unsigned u32x4 __attribute__((ext_vector_type(4)));
constexpr int BM = 256, BK = 64, HALF = 128, HTB = HALF * BK * 2  , STAGE_BYTES = 8 * HTB, NXCD = 8, WGM = 8;

__host__ __device__ __forceinline__ int lds_byte(int r, int c) { const int st = (r >> 4) * 2 + (c >> 5), rr = r & 15, cc = c & 31, ob = rr * 64 + cc * 2; return st * 1024 + (ob ^ (((ob >> 9) & 1) << 5)); }
__host__ __device__ __forceinline__ void stage_rc(int b, int& R, int& C) { const int st = b / 1024, sb = b % 1024, swz = sb ^ (((sb >> 9) & 1) << 5); R = (st >> 1) * 16 + swz / 64; C = (st & 1) * 32 + (swz % 64) / 2; }
__host__ __device__ __forceinline__ int perm32(int rho) { const int n = rho >> 4, i = rho & 15; return 8 * (i >> 2) + 4 * n + (i & 3); }

struct Unit { int pm, pn, e, mt, nv; };
struct Gemm { const bf16_t* A; const bf16_t* Bt; int M, N, K; };

struct StaticOrder {
    int nM, nN, nwg, G, c;
    __host__ __device__ void init(int M, int N, int G_, int c_) { nM = M / BM; nN = N / BM; nwg = nM * nN; G = G_; c = c_; }
    __host__ __device__ bool next(int i, Unit& u) const {
        const long L = (long)i * G + c; if (L >= nwg) return false;
        int wgid = (int)L; { const int q = nwg / NXCD, r = nwg % NXCD, xcd = wgid % NXCD, off = wgid / NXCD; wgid = (xcd < r ? xcd * (q + 1) : r * (q + 1) + (xcd - r) * q) + off; }
        const int nig = WGM * nN, gid = wgid / nig, fm = gid * WGM, gsz = (nM - fm) < WGM ? (nM - fm) : WGM;
        u.pm = fm + ((wgid % nig) % gsz); u.pn = (wgid % nig) / gsz; u.e = 0; u.mt = 0; u.nv = 256; return true;
    }
    __device__ __forceinline__ void a_ready(const Unit&) const {}
    __device__ __forceinline__ void done(const Unit&) const {}
};

__device__ __forceinline__ unsigned cvt_pk_bf16(float lo, float hi) { unsigned r; asm volatile("v_cvt_pk_bf16_f32 %0, %1, %2" : "=v"(r) : "v"(lo), "v"(hi)); return r; }
typedef float f32x2 __attribute__((ext_vector_type(2)));
__device__ __forceinline__ f32x2 gelu_pk(f32x2 v) {
    const f32x2 av = __builtin_elementwise_abs(v), d = av * 0.2316418882f + 1.0f;
    f32x2 t; t.x = __builtin_amdgcn_rcpf(d.x); t.y = __builtin_amdgcn_rcpf(d.y);
    f32x2 q = t * 0.5307027145f + (-0.7265760135f); q = q * t + 0.7107068705f; q = q * t + (-0.142248368f); q = q * t + 0.127414796f; q = q * t;
    const f32x2 s = (v * v) * (-0.72134752044f);
    f32x2 e; e.x = __builtin_amdgcn_exp2f(s.x); e.y = __builtin_amdgcn_exp2f(s.y);
    const f32x2 m = v * (q * e), r = v - m;
    f32x2 o; o.x = v.x < 0.f ? m.x : r.x; o.y = v.y < 0.f ? m.y : r.y; return o;
}

struct EpiStoreBf16 {
    static constexpr bool PERM = true, AFTER_DRAIN = false;
    bf16_t* O; int ldc;
    __device__ __forceinline__ void operator()(const f32x4 (&acc)[2][2][4][2], const Unit& u, int wr, int wc, int fr, int fq) const {
        const int row0 = u.pm * BM + wr * 64 + fr, col0 = u.pn * BM + wc * 32 + 8 * fq;
#pragma unroll
        for (int ai = 0; ai < 2; ++ai)
#pragma unroll
            for (int m = 0; m < 4; ++m) { bf16_t* rowp = O + (size_t)(row0 + ai * HALF + m * 16) * ldc + col0;
#pragma unroll
                for (int bj = 0; bj < 2; ++bj) { const f32x4 v0 = acc[ai][bj][m][0], v1 = acc[ai][bj][m][1];
                    u32x4 w; w.x = cvt_pk_bf16(v0[0], v0[1]); w.y = cvt_pk_bf16(v0[2], v0[3]); w.z = cvt_pk_bf16(v1[0], v1[1]); w.w = cvt_pk_bf16(v1[2], v1[3]);
                    *(u32x4*)(rowp + bj * HALF) = w; } }
    }
};
__device__ __forceinline__ float silu_f(float x) { return x * __builtin_amdgcn_rcpf(1.0f + __builtin_amdgcn_exp2f(-1.4426950408889634f * x)); }
struct EpiMoeGU {
    static constexpr bool PERM = true, AFTER_DRAIN = false;
    bf16_t* H;
    __device__ __forceinline__ void operator()(const f32x4 (&acc)[2][2][4][2], const Unit& u, int wr, int wc, int fr, int fq) const {
        const int row0 = u.pm * BM + wr * 64 + fr, hc0 = (u.pn & 3) * 128 + wc * 32 + 8 * fq;
#pragma unroll
        for (int ai = 0; ai < 2; ++ai)
#pragma unroll
            for (int m = 0; m < 4; ++m) { bf16_t* rowp = H + (size_t)(row0 + ai * HALF + m * 16) * 512 + hc0;
                const f32x4 g0 = acc[ai][0][m][0], g1 = acc[ai][0][m][1], u0 = acc[ai][1][m][0], u1 = acc[ai][1][m][1];
                u32x4 w; w.x = cvt_pk_bf16(silu_f(g0[0]) * u0[0], silu_f(g0[1]) * u0[1]); w.y = cvt_pk_bf16(silu_f(g0[2]) * u0[2], silu_f(g0[3]) * u0[3]);
                w.z = cvt_pk_bf16(silu_f(g1[0]) * u1[0], silu_f(g1[1]) * u1[1]); w.w = cvt_pk_bf16(silu_f(g1[2]) * u1[2], silu_f(g1[3]) * u1[3]);
                *(u32x4*)rowp = w; }
    }
};
struct EpiMoeDown {
    static constexpr bool PERM = true, AFTER_DRAIN = false;
    bf16_t* F; const int* list; int T;
    __device__ __forceinline__ void operator()(const f32x4 (&acc)[2][2][4][2], const Unit& u, int wr, int wc, int fr, int fq) const {
        const int* lb = list + u.e * 16384 + u.mt * BM; const int col0 = (u.pn & 3) * BM + wc * 32 + 8 * fq;
#pragma unroll
        for (int ai = 0; ai < 2; ++ai)
#pragma unroll
            for (int m = 0; m < 4; ++m) { const int rl = ai * HALF + wr * 64 + m * 16 + fr;
                if (rl < u.nv) { const int ent = lb[rl]; bf16_t* rowp = F + ((size_t)(ent & 1) * T + (ent >> 1)) * 1024 + col0;
#pragma unroll
                    for (int bj = 0; bj < 2; ++bj) { const f32x4 v0 = acc[ai][bj][m][0], v1 = acc[ai][bj][m][1];
                        u32x4 w; w.x = cvt_pk_bf16(v0[0], v0[1]); w.y = cvt_pk_bf16(v0[2], v0[3]); w.z = cvt_pk_bf16(v1[0], v1[1]); w.w = cvt_pk_bf16(v1[2], v1[3]);
                        *(u32x4*)(rowp + bj * HALF) = w; } } }
    }
};
struct MoeOrder {
    const PG8_LAS int* cntl; const int* list; int G, c;
    __device__ __forceinline__ bool next(int i, Unit& u) const {
        const int L = i * G + c, tile = L >> 2; int acc = 0;
#pragma unroll 1
        for (int e = 0; e < 16; ++e) { const int ce = cntl[e], nte = (ce + BM - 1) >> 8;
            if (tile < acc + nte) { u.e = e; u.mt = tile - acc; u.pm = tile; u.pn = e * 4 + (L & 3); const int rem = ce - u.mt * BM; u.nv = rem < BM ? rem : BM; return true; }
            acc += nte; }
        return false;
    }
    __device__ __forceinline__ int gather_row(const Unit& u, int r) const { const int* lb = list + u.e * 16384 + u.mt * BM; return lb[r < u.nv ? r : 0] >> 1; }
    __device__ __forceinline__ void a_ready(const Unit&) const {}
    __device__ __forceinline__ void done(const Unit&) const {}
};

template <class Epi, class Sched, bool ALIGN_EPI, bool GATHER>
__device__ __forceinline__ void gemm_phase(PG8_LAS unsigned char* lds, const Gemm g, const Sched& S, const Epi& E, const int tid) {
    const int wid = __builtin_amdgcn_readfirstlane(tid >> 6), lane = tid & 63, wr = wid >> 2, wc = wid & 3, fr = lane & 15, fq = lane >> 4;
    const int K = g.K, nt = K / BK;
    unsigned voffB[2], vC[2][2], vN[2][2]; int stR[2], stC[2];
#pragma unroll
    for (int i = 0; i < 2; ++i) { int R, C; stage_rc(tid * 16 + i * 8192, R, C); stR[i] = R; stC[i] = C; const int Rb = Epi::PERM ? ((R & ~31) + perm32(R & 31)) : R;
        voffB[i] = (unsigned)(Rb * K + C) * 2u; }
    const size_t kstep = (size_t)(BK * 2);
    const size_t hstep = (size_t)HALF * K * 2;
    const size_t tstep = 2 * hstep;
    const unsigned ldsw = (unsigned)wid * 1024u;
    const int aoff = lds_byte(wr * 64 + fr, fq * 8), boff = lds_byte(wc * 32 + fr, fq * 8);
#define PG8_SA(b, h) (((b) * 2 + (h)) * HTB)
#define PG8_SB(b, h) ((4 + (b) * 2 + (h)) * HTB)
#define PG8_STAGE(bufoff, gbase, voff) do { _Pragma("unroll") for (int _i = 0; _i < 2; ++_i) \
        __builtin_amdgcn_global_load_lds((const unsigned*)((const char*)(gbase) + (voff)[_i]), (PG8_LAS unsigned*)(lds + (bufoff) + ldsw + _i * 8192), 16, 0, 0); } while (0)
#define PG8_LDA(dst, b, h) do { _Pragma("unroll") for (int m = 0; m < 4; ++m) _Pragma("unroll") for (int k = 0; k < 2; ++k) dst[m][k] = *(const PG8_LAS bf16x8*)(lds + PG8_SA(b, h) + aoff + m * 2048 + k * 1024); } while (0)
#define PG8_LDB(dst, b, h) do { _Pragma("unroll") for (int n = 0; n < 2; ++n) _Pragma("unroll") for (int k = 0; k < 2; ++k) dst[n][k] = *(const PG8_LAS bf16x8*)(lds + PG8_SB(b, h) + boff + n * 2048 + k * 1024); } while (0)
#define PG8_MMA(ai, bj, At, Bt) do { __builtin_amdgcn_s_setprio(1); _Pragma("unroll") for (int m = 0; m < 4; ++m) _Pragma("unroll") for (int n = 0; n < 2; ++n) _Pragma("unroll") for (int k = 0; k < 2; ++k) \
        acc[ai][bj][m][n] = __builtin_amdgcn_mfma_f32_16x16x32_bf16(Bt[n][k], At[m][k], acc[ai][bj][m][n], 0, 0, 0); __builtin_amdgcn_s_setprio(0); } while (0)
#define PG8_WAIT_V(n) asm volatile("s_waitcnt vmcnt(" #n ")" ::: "memory")
#define PG8_WAIT_L(n) asm volatile("s_waitcnt lgkmcnt(" #n ")" ::: "memory")
#define PG8_BAR __builtin_amdgcn_s_barrier()
#define PG8_SCHED __builtin_amdgcn_sched_barrier(0)
#define PG8_SETV(v, u) do { _Pragma("unroll") for (int _h = 0; _h < 2; ++_h) _Pragma("unroll") for (int _i = 0; _i < 2; ++_i) { \
        if constexpr (GATHER) { const int _tok = S.gather_row(u, _h * HALF + stR[_i]); v[_h][_i] = (unsigned)(_tok * K + stC[_i]) * 2u; } \
        else v[_h][_i] = (unsigned)((_h * HALF + stR[_i]) * K + stC[_i]) * 2u; } } while (0)
#define PG8_STAGE_SEL(bufoff, gbase, h) do { _Pragma("unroll") for (int _i = 0; _i < 2; ++_i) { const unsigned _o = (GATHER && last) ? vN[h][_i] : vC[h][_i]; \
        __builtin_amdgcn_global_load_lds((const unsigned*)((const char*)(gbase) + _o), (PG8_LAS unsigned*)(lds + (bufoff) + ldsw + _i * 8192), 16, 0, 0); } } while (0)
    Unit cur, nxt; int ui = 0;
    if (!S.next(0, cur)) return;
    f32x4 acc[2][2][4][2];
#pragma unroll
    for (int a = 0; a < 2; ++a)
#pragma unroll
        for (int b = 0; b < 2; ++b)
#pragma unroll
            for (int m = 0; m < 4; ++m)
#pragma unroll
                for (int n = 0; n < 2; ++n) acc[a][b][m][n] = (f32x4){0.f, 0.f, 0.f, 0.f};
    bf16x8 At[4][2], B0[2][2], B1[2][2];
    PG8_SETV(vC, cur);
    if constexpr (GATHER) asm volatile("s_waitcnt vmcnt(0)" : "+v"(vC[0][0]), "+v"(vC[0][1]), "+v"(vC[1][0]), "+v"(vC[1][1]) :: "memory");
    const char* cA = GATHER ? (const char*)g.A : (const char*)g.A + (size_t)cur.pm * tstep; const char* cB = (const char*)g.Bt + (size_t)cur.pn * tstep;
    S.a_ready(cur);
    PG8_STAGE(PG8_SB(0, 0), cB, voffB); PG8_STAGE(PG8_SB(0, 1), cB + hstep, voffB); PG8_STAGE(PG8_SA(0, 0), cA, vC[0]); PG8_STAGE(PG8_SA(0, 1), cA, vC[1]);
    if (wr == 1) PG8_BAR;
    PG8_WAIT_V(2); PG8_BAR;
    PG8_STAGE(PG8_SB(1, 0), cB + kstep, voffB); PG8_STAGE(PG8_SA(1, 0), cA + kstep, vC[0]); PG8_STAGE(PG8_SB(1, 1), cB + hstep + kstep, voffB);
    PG8_WAIT_V(6); PG8_BAR;
    for (;;) {
        const bool has_next = S.next(ui + 1, nxt);
        if constexpr (GATHER) {
            if (has_next) { PG8_SETV(vN, nxt); asm volatile("s_waitcnt vmcnt(0)" : "+v"(vN[0][0]), "+v"(vN[0][1]), "+v"(vN[1][0]), "+v"(vN[1][1]) :: "memory"); }
            else {
#pragma unroll
                for (int h = 0; h < 2; ++h)
#pragma unroll
                    for (int i = 0; i < 2; ++i) vN[h][i] = vC[h][i]; }
        }
        const char* nA = GATHER ? cA : (has_next ? (const char*)g.A + (size_t)nxt.pm * tstep : cA); const char* nB = has_next ? (const char*)g.Bt + (size_t)nxt.pn * tstep : cB;
        for (int t = 0; t < nt; t += 2) {
            const bool last = (t == nt - 2);
            const char* a1 = cA + (size_t)(t + 1) * kstep;
            const char* a2 = last ? nA : cA + (size_t)(t + 2) * kstep; const char* b2 = last ? nB : cB + (size_t)(t + 2) * kstep;
            const char* a3 = a2 + kstep; const char* b3 = b2 + kstep;
            if (last && has_next) S.a_ready(nxt);
            PG8_LDB(B0, 0, 0); PG8_LDB(B1, 0, 1); PG8_SCHED; PG8_LDA(At, 0, 0); PG8_STAGE(PG8_SA(1, 1), a1, vC[1]);
            PG8_WAIT_V(8); PG8_WAIT_L(0); PG8_BAR; PG8_MMA(0, 0, At, B0); PG8_MMA(0, 1, At, B1); PG8_BAR; PG8_SCHED;
            PG8_LDA(At, 0, 1); PG8_STAGE(PG8_SB(0, 0), b2, voffB); PG8_STAGE(PG8_SB(0, 1), b2 + hstep, voffB); PG8_STAGE_SEL(PG8_SA(0, 0), a2, 0);
            PG8_WAIT_V(8); PG8_WAIT_L(0); PG8_BAR; PG8_MMA(1, 0, At, B0); PG8_MMA(1, 1, At, B1); PG8_BAR; PG8_SCHED;
            PG8_LDB(B0, 1, 0); PG8_LDB(B1, 1, 1); PG8_SCHED; PG8_LDA(At, 1, 0); PG8_STAGE_SEL(PG8_SA(0, 1), a2, 1);
            PG8_WAIT_V(8); PG8_WAIT_L(0); PG8_BAR; PG8_MMA(0, 0, At, B0); PG8_MMA(0, 1, At, B1); PG8_BAR; PG8_SCHED;
            PG8_LDA(At, 1, 1); PG8_STAGE(PG8_SB(1, 0), b3, voffB); PG8_STAGE(PG8_SB(1, 1), b3 + hstep, voffB); PG8_STAGE_SEL(PG8_SA(1, 0), a3, 0);
            PG8_WAIT_V(8); PG8_WAIT_L(0); PG8_BAR; PG8_MMA(1, 0, At, B0); PG8_MMA(1, 1, At, B1); PG8_BAR; PG8_SCHED;
        }
        if constexpr (ALIGN_EPI) { if (wr == 0) PG8_BAR; }
        E(acc, cur, wr, wc, fr, fq); S.done(cur);
        if (!has_next) break;
#pragma unroll
        for (int a = 0; a < 2; ++a)
#pragma unroll
            for (int b = 0; b < 2; ++b)
#pragma unroll
                for (int m = 0; m < 4; ++m)
#pragma unroll
                    for (int n = 0; n < 2; ++n) acc[a][b][m][n] = (f32x4){0.f, 0.f, 0.f, 0.f};
        cur = nxt; cA = nA; cB = nB; ++ui;
        if constexpr (GATHER) {
#pragma unroll
            for (int h = 0; h < 2; ++h)
#pragma unroll
                for (int i = 0; i < 2; ++i) vC[h][i] = vN[h][i]; }
        if constexpr (ALIGN_EPI) { if (wr == 1) PG8_BAR; }
    }
    PG8_WAIT_V(0);
    if constexpr (!ALIGN_EPI) { if (wr == 0) PG8_BAR; }
    PG8_BAR;
#undef PG8_SA
#undef PG8_SB
#undef PG8_STAGE
#undef PG8_LDA
#undef PG8_LDB
#undef PG8_MMA
#undef PG8_WAIT_V
#undef PG8_WAIT_L
#undef PG8_BAR
#undef PG8_SCHED
#undef PG8_SETV
#undef PG8_STAGE_SEL
}
}
#define GAS __attribute__((address_space(1)))
#define LAS __attribute__((address_space(3)))
typedef unsigned short bf16;
typedef unsigned v4u __attribute__((ext_vector_type(4)));
typedef float f32x4 __attribute__((ext_vector_type(4)));
typedef short bf16x8 __attribute__((ext_vector_type(8)));
typedef GAS unsigned gu32;
typedef GAS unsigned long long gu64;
#define RLX_AGENT __ATOMIC_RELAXED, __HIP_MEMORY_SCOPE_AGENT
#define LDS_WAIT() asm volatile("s_waitcnt lgkmcnt(0)" ::: "memory")
#define VM_WAIT() asm volatile("s_waitcnt vmcnt(0)" ::: "memory")
__device__ __forceinline__ unsigned long long rt() { return __builtin_amdgcn_s_memrealtime(); }
__device__ __forceinline__ unsigned f2bf(float f) { unsigned u = __builtin_bit_cast(unsigned, f); return (u + 0x7fffu + ((u >> 16) & 1u)) >> 16; }
__device__ __forceinline__ unsigned pk2(float lo, float hi) { return f2bf(lo) | (f2bf(hi) << 16); }

#define XB_TMO      128
#define XB_XCNT(j)  (256  + 64 * (j))
#define XB_XSUB(j)  (1280 + 64 * (j))
#define XB_XGEN(j)  (2304 + 64 * (j))
#define XB_TOP      3328
#define XB_TOPGEN   3392
#define XCD_BAR_WORDS 3456
#define XB_SPIN_CAP (1u << 18)

__device__ __forceinline__ unsigned xb_ld(unsigned* p)              { return __hip_atomic_load(p, __ATOMIC_RELAXED, __HIP_MEMORY_SCOPE_AGENT); }
__device__ __forceinline__ unsigned xb_add(unsigned* p, unsigned v) { return __hip_atomic_fetch_add(p, v, __ATOMIC_RELAXED, __HIP_MEMORY_SCOPE_AGENT); }
__device__ __forceinline__ unsigned xb_xcc_id() { return (unsigned)__builtin_amdgcn_s_getreg((3 << 11) | 20) & 0xFu; }
#define XB_SPIN(cond, bar) do { unsigned _sp = 0; while (cond) { __builtin_amdgcn_s_sleep(1); \
    if ((++_sp & 255u) == 0u) { if (xb_ld(&(bar)[XB_TMO])) break; if (_sp > XB_SPIN_CAP) { atomicAdd(&(bar)[XB_TMO], 1u); break; } } } } while (0)

struct XcdBarrier {
    unsigned* bar; unsigned x;
    volatile LAS unsigned* st;
};

__device__ __forceinline__ XcdBarrier xcd_barrier_post(unsigned* bar, volatile LAS unsigned* st) {
    XcdBarrier b; b.bar = bar; b.x = xb_xcc_id(); b.st = st;
    if (threadIdx.x == 0) (void)xb_add(&bar[XB_XCNT(b.x)], 1u);
    return b;
}
__device__ __forceinline__ void xcd_barrier_complete(unsigned* bar, unsigned x, unsigned& nloc, unsigned& nx) {
    const unsigned G = gridDim.x * gridDim.y * gridDim.z;
    unsigned sum, cnt, mine, sp = 0u;
    for (;;) {
        sum = 0u; cnt = 0u; mine = 0u;
#pragma unroll
        for (unsigned j = 0; j < 16; ++j) { const unsigned c = xb_ld(&bar[XB_XCNT(j)]); sum += c; cnt += (c > 0u) ? 1u : 0u; mine = (j == x) ? c : mine; }
        if (sum == G) break;
        __builtin_amdgcn_s_sleep(1);
        if ((++sp & 255u) == 0u) { if (xb_ld(&bar[XB_TMO])) break; if (sp > XB_SPIN_CAP) { atomicAdd(&bar[XB_TMO], 1u); break; } }
    }
    nloc = mine > 0u ? mine : 1u; nx = cnt > 0u ? cnt : 1u;
}

__device__ __forceinline__ void xcd_barrier(const XcdBarrier& b) {
    asm volatile("s_waitcnt vmcnt(0)" ::: "memory");
    __syncthreads();
    if (threadIdx.x == 0) {
        unsigned* bar = b.bar;
        __builtin_amdgcn_s_waitcnt(0);
        unsigned nloc = b.st[0], nx = b.st[1];
        if (nloc == 0u) { xcd_barrier_complete(bar, b.x, nloc, nx); b.st[0] = nloc; b.st[1] = nx; }
        const unsigned old = xb_add(&bar[XB_XSUB(b.x)], 1u);
        const unsigned gen = old / nloc;
        if (old + 1u == (gen + 1u) * nloc) {
            __builtin_amdgcn_fence(__ATOMIC_RELEASE, "agent");
            asm volatile("s_waitcnt vmcnt(0)" ::: "memory");
            const unsigned og = xb_add(&bar[XB_TOP], 1u);
            const unsigned tg = og / nx;
            if (og + 1u == (tg + 1u) * nx) xb_add(&bar[XB_TOPGEN], 1u);
            else XB_SPIN(xb_ld(&bar[XB_TOPGEN]) == tg, bar);
            __builtin_amdgcn_fence(__ATOMIC_ACQUIRE, "agent");
            xb_add(&bar[XB_XGEN(b.x)], 1u);
            asm volatile("s_waitcnt vmcnt(0)" ::: "memory");
        } else {
            XB_SPIN(xb_ld(&bar[XB_XGEN(b.x)]) == gen, bar);
            __builtin_amdgcn_fence(__ATOMIC_ACQUIRE, "agent");
            asm volatile("s_waitcnt vmcnt(0)" ::: "memory");
        }
    }
    __syncthreads();
}

constexpr int T = 16384, D = 1024, SEQ = 4096, NB = 4, INW = 5376, NL = 4;
constexpr int C_Q = 0, C_K = 1024, C_V = 1152, C_LX = 1280, C_LG = 2304, C_GA = 3328, C_GB = 4352;
constexpr int NE = 16, FF = 512;
constexpr float ALPHA = 1.681792830507429f;
constexpr float LN_EPS = 1e-5f;
constexpr float LOG2E = 1.4426950408889634f;
constexpr size_t MiB = 1u << 20;
constexpr size_t WS_CTL = 0, CTL_ZERO_BYTES = 1 * MiB;
constexpr int CW_TMO = 0, CW_BAR = 4096, CW_CNT = 16384;
constexpr size_t WS_MOD = 1 * MiB;
constexpr size_t WS_SUM = 2 * MiB;
constexpr size_t WS_EIDX = 3 * MiB;
constexpr size_t WS_EW = 3 * MiB + 512 * 1024;
constexpr size_t WS_LIST = 4 * MiB;
constexpr size_t WS_LRUW = 5 * MiB;
constexpr size_t WS_WIN = 6 * MiB;
constexpr size_t WS_WO = 17 * MiB;
constexpr size_t WS_WGU = 19 * MiB;
constexpr size_t WS_WD = 51 * MiB;
constexpr size_t WS_U = 68 * MiB;
constexpr size_t WS_P = 100 * MiB;
constexpr size_t WS_Y = 268 * MiB;
constexpr size_t WS_H = 300 * MiB;
constexpr size_t WS_END = 336 * MiB;
constexpr size_t WS_TA = 336 * MiB, WS_TI = 400 * MiB, WS_TZ = 464 * MiB, WS_END_HYB = 528 * MiB;

constexpr int NWAVES = 8;
constexpr int RING_OFF = 0, RING_BYTES = 131072;
constexpr int LDSCTL_OFF = RING_BYTES;
constexpr int LDS_BYTES = 147456;

typedef float f32x16 __attribute__((ext_vector_type(16)));
typedef unsigned u32x2 __attribute__((ext_vector_type(2)));
__device__ __forceinline__ float bf2f(unsigned v) { return __uint_as_float(v << 16); }
__device__ __forceinline__ float fast_sigmoid(float x) { return __builtin_amdgcn_rcpf(1.0f + __builtin_amdgcn_exp2f(-LOG2E * x)); }
__device__ __forceinline__ float gelu_tanh_f(float x) { const float u = 0.7978845608028654f * (x + 0.044715f * x * x * x); return x * fast_sigmoid(2.0f * u); }
__device__ __forceinline__ float wave_sum(float v) {
#pragma unroll
    for (int o = 1; o < 64; o <<= 1) v += __shfl_xor(v, o);
    return v;
}
__constant__ int c_bucket[128] = {0, 1, 2, 3, 4, 5, 6, 7, 8, 9, 10, 11, 12, 13, 14, 15, 16, 16, 16, 17, 17, 18, 18, 18, 19, 19, 19, 20, 20, 20, 20, 21, 21, 21, 21, 22, 22, 22, 22, 22, 23, 23, 23, 23, 23, 23, 24, 24, 24, 24, 24, 24, 25, 25, 25, 25, 25, 25, 25, 26, 26, 26, 26, 26, 26, 26, 26, 27, 27, 27, 27, 27, 27, 27, 27, 27, 27, 28, 28, 28, 28, 28, 28, 28, 28, 28, 28, 29, 29, 29, 29, 29, 29, 29, 29, 29, 29, 29, 29, 30, 30, 30, 30, 30, 30, 30, 30, 30, 30, 30, 30, 30, 30, 31, 31, 31, 31, 31, 31, 31, 31, 31, 31, 31, 31, 31, 31, 31};

struct Ptrs {
    const float *x, *c, *ada_w, *ada_b, *w_in, *attn_sink, *rel_bias, *conv_w, *conv_b, *lru_wa, *lru_ba, *lru_wx, *lru_bx, *lru_lambda, *w_out, *ln1_g, *ln1_b, *router_w, *router_b, *moe_wg, *moe_wu, *moe_wd, *ln2_g, *ln2_b;
    float* out; unsigned char* ws;
};

__device__ __forceinline__ void transpose_item(const float* W, int K, int N, bf16* WT, int row_off, LAS float* scr, int item, int lane) {
    const int nblk = N / 32, kb = item / nblk, nb = item % nblk, k0 = 64 * kb, n0 = 32 * nb;
#pragma unroll 8
    for (int i = 0; i < 32; ++i) { const int kk = 2 * i + (lane >> 5); scr[kk * 33 + (lane & 31)] = W[(size_t)(k0 + kk) * N + n0 + (lane & 31)]; }
    LDS_WAIT(); asm volatile("" ::: "memory");
    const int c = lane & 7;
#pragma unroll
    for (int j = 0; j < 4; ++j) { const int n = (lane >> 3) + 8 * j; const LAS float* s = scr + (8 * c) * 33 + n;
        v4u o; o.x = pk2(s[0 * 33], s[1 * 33]); o.y = pk2(s[2 * 33], s[3 * 33]); o.z = pk2(s[4 * 33], s[5 * 33]); o.w = pk2(s[6 * 33], s[7 * 33]);
        *(GAS v4u*)(WT + (size_t)(row_off + n0 + n) * K + k0 + 8 * c) = o; }
    LDS_WAIT(); asm volatile("" ::: "memory");
}
__device__ __forceinline__ void convert_layer(const Ptrs& p, int l, LAS unsigned char* lds, int gw, int NGW, int wave, int lane) {
    LAS float* scr = (LAS float*)(lds + RING_OFF + wave * 16384);
    constexpr int I_IN = (D / 64) * (INW / 32), I_O = (D / 64) * (D / 32), I_GU = 2 * NE * 256, I_D = NE * 256, I_L = 128;
    constexpr int NITEMS = I_IN + I_O + I_GU + I_D + I_L;
    bf16* WinT = (bf16*)(p.ws + WS_WIN); bf16* WoT = (bf16*)(p.ws + WS_WO); bf16* WguT = (bf16*)(p.ws + WS_WGU); bf16* WdT = (bf16*)(p.ws + WS_WD); bf16* waT = (bf16*)(p.ws + WS_LRUW); bf16* wxT = waT + 8 * 128 * 128;
    for (int it = gw; it < NITEMS; it += NGW) {
        int r = it;
        if (r < I_IN) { transpose_item(p.w_in + (size_t)l * D * INW, D, INW, WinT, 0, scr, r, lane); continue; } r -= I_IN;
        if (r < I_O) { transpose_item(p.w_out + (size_t)l * D * D, D, D, WoT, 0, scr, r, lane); continue; } r -= I_O;
        if (r < I_GU) { const int mat = r / (NE * 256); const int q = r % (NE * 256); const int e = q / 256, ti = q % 256; const int n0 = 32 * (ti % 16);
            const float* W = (mat ? p.moe_wu : p.moe_wg) + ((size_t)l * NE + e) * D * FF;
            transpose_item(W, D, FF, WguT, e * 1024 + (n0 / 128) * 256 + mat * 128 + (n0 % 128) - n0, scr, ti, lane); continue; } r -= I_GU;
        if (r < I_D) { const int e = r / 256, ti = r % 256; transpose_item(p.moe_wd + ((size_t)l * NE + e) * FF * D, FF, D, WdT, e * 1024, scr, ti, lane); continue; } r -= I_D;
        { const int mat = r / 64; const int q = r % 64; const int hb = q / 8, ti = q % 8;
            transpose_item((mat ? p.lru_wx : p.lru_wa) + ((size_t)l * 8 + hb) * 128 * 128, 128, 128, mat ? wxT : waT, hb * 128, scr, ti, lane); }
    }
}
__device__ __forceinline__ void mod_item(const Ptrs& p, int item, LAS unsigned char* lds, int tid, int wave, int lane) {
    LAS float* ca = (LAS float*)lds;
    LAS float* red = (LAS float*)(lds + 16384);
    const int l = item / 24, j0 = (item % 24) * 256;
    for (int i = tid; i < NB * D; i += 512) { const float v = p.c[i]; ca[i] = v * fast_sigmoid(v); }
    __syncthreads();
    f32x4 acc[NB];
#pragma unroll
    for (int b = 0; b < NB; ++b) acc[b] = (f32x4){0.f, 0.f, 0.f, 0.f};
    const float* w = p.ada_w + (size_t)l * D * 6144 + j0 + 4 * lane;
#pragma unroll 8
    for (int kk = 0; kk < 128; ++kk) { const int k = wave * 128 + kk; const f32x4 wv = *(const f32x4*)(w + (size_t)k * 6144);
#pragma unroll
        for (int b = 0; b < NB; ++b) acc[b] += wv * ca[b * D + k]; }
#pragma unroll
    for (int b = 0; b < NB; ++b) *(LAS f32x4*)(red + (wave * NB + b) * 256 + 4 * lane) = acc[b];
    __syncthreads();
    float* mod = (float*)(p.ws + WS_MOD);
    for (int i = tid; i < NB * 256; i += 512) { const int b = i / 256, jj = i % 256; float s = 0.f;
#pragma unroll
        for (int w8 = 0; w8 < 8; ++w8) s += red[(w8 * NB + b) * 256 + jj];
        mod[((size_t)l * NB + b) * 6144 + j0 + jj] = s + p.ada_b[l * 6144 + j0 + jj]; }
    __syncthreads();
}
__device__ __forceinline__ void modulate_rows(const float* x, const float* mod_l, bf16* U, int gw, int NGW, int lane) {
    for (int row = gw; row < T; row += NGW) { const float* m = mod_l + (size_t)(row / SEQ) * 6144;
#pragma unroll
        for (int j = 0; j < 4; ++j) { const int col = 4 * lane + 256 * j; const f32x4 xv = *(const f32x4*)(x + (size_t)row * D + col), sh = *(const f32x4*)(m + col), sc = *(const f32x4*)(m + 1024 + col);
            const f32x4 u = xv * (sc + 1.0f) + sh; u32x2 o; o.x = pk2(u[0], u[1]); o.y = pk2(u[2], u[3]); *(u32x2*)(U + (size_t)row * D + col) = o; } }
}

constexpr int KS_STRIDE = 144;
constexpr int VT_STRIDE = 520;
constexpr int XC_STRIDE = 272;
constexpr int LB_K = 0, LB_V = 256 * KS_STRIDE  , LB_TBL = LB_V + 64 * VT_STRIDE  , LB_XC = LB_TBL + 8 * 192 * 4  , LB_END = LB_XC + 4 * 32 * XC_STRIDE  ;
constexpr int LB_CARRY = LB_END;
static_assert(LB_CARRY + 2048 <= RING_BYTES, "phase B LDS");

template <bool FINAL>
__device__ __forceinline__ void phase_b(const Ptrs& p, int l, LAS unsigned char* lds, int vcu, int G) {
    const bf16* P = (const bf16*)(p.ws + WS_P); bf16* Y = (bf16*)(p.ws + WS_Y);
    float* SA = (float*)(p.ws + WS_SUM); float* SB = SA + NB * 32 * 1024;
    const bf16* waT = (const bf16*)(p.ws + WS_LRUW); const bf16* wxT = waT + 8 * 128 * 128;
    for (int unit = vcu; unit < 256; unit += G) {
        int tid = threadIdx.x; asm volatile("" : "+v"(tid));
        const int lane = tid & 63, w = __builtin_amdgcn_readfirstlane(tid >> 6), l31 = lane & 31, hi = lane >> 5;
        const int b = unit >> 6, n = (unit & 63) >> 1, half = unit & 1;
        const int row0 = b * SEQ + n * 128;
        __syncthreads();
        if (FINAL) {
#pragma unroll
            for (int it = 0; it < 4; ++it) { const int idx = it * 512 + tid, r = idx >> 3, ch = idx & 7;
                v4u v = (v4u){0u, 0u, 0u, 0u};
                if (n > 0 || r >= 128) v = *(const v4u*)(P + (size_t)(row0 - 128 + r) * INW + C_K + half * 64 + ch * 8);
                *(LAS v4u*)(lds + LB_K + r * KS_STRIDE + ch * 16) = v; }
            { const int kg = tid >> 3, dc = tid & 7; v4u v[4];
#pragma unroll
                for (int i = 0; i < 4; ++i) { const int r = 4 * kg + i; v[i] = (v4u){0u, 0u, 0u, 0u};
                    if (n > 0 || r >= 128) v[i] = *(const v4u*)(P + (size_t)(row0 - 128 + r) * INW + C_V + half * 64 + dc * 8); }
#pragma unroll
                for (int d2 = 0; d2 < 4; ++d2) {
                    const unsigned a0 = v[0][d2], a1 = v[1][d2], a2 = v[2][d2], a3 = v[3][d2];
                    u32x2 lo, hh; lo.x = (a0 & 0xffffu) | (a1 << 16); lo.y = (a2 & 0xffffu) | (a3 << 16); hh.x = (a0 >> 16) | (a1 & 0xffff0000u); hh.y = (a2 >> 16) | (a3 & 0xffff0000u);
                    *(LAS u32x2*)(lds + LB_V + (dc * 8 + 2 * d2) * VT_STRIDE + kg * 8) = lo; *(LAS u32x2*)(lds + LB_V + (dc * 8 + 2 * d2 + 1) * VT_STRIDE + kg * 8) = hh; } }
#pragma unroll
            for (int i = 0; i < 3; ++i) { const int idx = tid + 512 * i, hd = idx / 192, xi = idx % 192, xx = xi - 32;
                float v = -INFINITY; if (xx >= 0 && xx < 128) v = p.rel_bias[c_bucket[127 - xx] * 16 + half * 8 + hd] * LOG2E;
                ((LAS float*)(lds + LB_TBL))[idx] = v; }
        }
        const int hbl = w >> 1, jb = (w & 1) * 64;
        const int hb = half * 4 + hbl;
        float hprev[2], atot[2];
#pragma unroll
        for (int dh = 0; dh < 2; ++dh) { const int ch = hb * 128 + jb + dh * 32 + l31;
            hprev[dh] = 0.f; atot[dh] = 1.f; (void)ch; }
        if (FINAL) {
            const size_t o0 = (size_t)b * 32 * 1024 + half * 512 + tid; float h = 0.f; int q = 0;
            for (; q + 8 <= n; q += 8) { float a8[8], b8[8];
#pragma unroll
                for (int u = 0; u < 8; ++u) { a8[u] = SA[o0 + (size_t)(q + u) * 1024]; b8[u] = SB[o0 + (size_t)(q + u) * 1024]; }
#pragma unroll
                for (int u = 0; u < 8; ++u) h = a8[u] * h + b8[u]; }
            for (; q < n; ++q) h = SA[o0 + (size_t)q * 1024] * h + SB[o0 + (size_t)q * 1024];
            ((LAS float*)(lds + LB_CARRY))[tid] = h; }
        const float sink2 = FINAL ? p.attn_sink[l * 16 + half * 8 + w] * LOG2E : 0.f;
#pragma unroll 1
        for (int c = 0; c < 4; ++c) {
            __syncthreads();
            { const int tg = tid >> 6, cg = tid & 63, chc = half * 512 + 8 * cg;
                const int t0 = row0 + 32 * c + 4 * tg;
                v4u xr[7];
#pragma unroll
                for (int i = 0; i < 7; ++i) { xr[i] = (v4u){0u, 0u, 0u, 0u}; if (n > 0 || c > 0 || tg > 0 || i >= 3) xr[i] = *(const v4u*)(P + (size_t)(t0 - 3 + i) * INW + C_LX + chc); }
                f32x4 cwv[5][2];
#pragma unroll
                for (int q = 0; q < 4; ++q) { cwv[q][0] = *(const f32x4*)(p.conv_w + ((size_t)l * 4 + q) * D + chc); cwv[q][1] = *(const f32x4*)(p.conv_w + ((size_t)l * 4 + q) * D + chc + 4); }
                cwv[4][0] = *(const f32x4*)(p.conv_b + l * D + chc); cwv[4][1] = *(const f32x4*)(p.conv_b + l * D + chc + 4);
#pragma unroll
                for (int k = 0; k < 4; ++k) { v4u o;
#pragma unroll
                    for (int d2 = 0; d2 < 4; ++d2) { float r2[2];
#pragma unroll
                        for (int e = 0; e < 2; ++e) { const int cc = 2 * d2 + e; float acc = cwv[4][cc >> 2][cc & 3];
#pragma unroll
                            for (int q = 0; q < 4; ++q) { const unsigned wd = xr[k + q][d2]; acc += cwv[q][cc >> 2][cc & 3] * (e ? bf2f(wd >> 16) : bf2f(wd & 0xffffu)); }
                            r2[e] = acc; }
                        o[d2] = pk2(r2[0], r2[1]); }
                    *(LAS v4u*)(lds + LB_XC + (cg >> 4) * (32 * XC_STRIDE) + (4 * tg + k) * XC_STRIDE + (cg & 15) * 16) = o; } }
            __syncthreads();
            f32x16 O[2];
            if (FINAL && c == 0) { hprev[0] = ((const LAS float*)(lds + LB_CARRY))[w * 64 + l31]; hprev[1] = ((const LAS float*)(lds + LB_CARRY))[w * 64 + 32 + l31]; }
            if (FINAL) {
                const int hq = half * 8 + w;
                bf16x8 qr[4];
#pragma unroll
                for (int ks = 0; ks < 4; ++ks) qr[ks] = *(const bf16x8*)(P + (size_t)(row0 + 32 * c + l31) * INW + C_Q + hq * 64 + 16 * ks + 8 * hi);
                f32x16 st[5];
#pragma unroll
                for (int jj = 0; jj < 5; ++jj) { st[jj] = (f32x16){};
#pragma unroll
                    for (int ks = 0; ks < 4; ++ks) { const bf16x8 kf = *(const LAS bf16x8*)(lds + LB_K + (32 * (c + jj) + l31) * KS_STRIDE + (16 * ks + 8 * hi) * 2);
                        st[jj] = __builtin_amdgcn_mfma_f32_32x32x16_bf16(kf, qr[ks], st[jj], 0, 0, 0); } }
                const LAS float* tb = (const LAS float*)(lds + LB_TBL) + w * 192 + (31 - l31 + 4 * hi);
                float m = sink2;
#pragma unroll
                for (int jj = 0; jj < 5; ++jj) { const bool dead = (n == 0) && (c + jj < 4);
#pragma unroll
                    for (int r = 0; r < 16; ++r) { float v = st[jj][r] * (0.125f * LOG2E) + tb[32 * jj + (r & 3) + 8 * (r >> 2)]; if (dead) v = -INFINITY; st[jj][r] = v; m = fmaxf(m, v); } }
                m = fmaxf(m, __shfl_xor(m, 32));
                float sum = 0.f;
#pragma unroll
                for (int jj = 0; jj < 5; ++jj)
#pragma unroll
                    for (int r = 0; r < 16; ++r) { const float e = __builtin_amdgcn_exp2f(st[jj][r] - m); st[jj][r] = e; sum += e; }
                sum += __shfl_xor(sum, 32);
                const float inv = __builtin_amdgcn_rcpf(sum + __builtin_amdgcn_exp2f(sink2 - m));
                O[0] = (f32x16){}; O[1] = (f32x16){};
#pragma unroll
                for (int jj = 0; jj < 5; ++jj)
#pragma unroll
                    for (int s2 = 0; s2 < 2; ++s2) {
                        v4u pw; pw.x = pk2(st[jj][8 * s2 + 0] * inv, st[jj][8 * s2 + 1] * inv); pw.y = pk2(st[jj][8 * s2 + 2] * inv, st[jj][8 * s2 + 3] * inv);
                        pw.z = pk2(st[jj][8 * s2 + 4] * inv, st[jj][8 * s2 + 5] * inv); pw.w = pk2(st[jj][8 * s2 + 6] * inv, st[jj][8 * s2 + 7] * inv);
                        const bf16x8 pa = __builtin_bit_cast(bf16x8, pw);
                        const int key0 = 32 * (c + jj) + 16 * s2 + 4 * hi;
#pragma unroll
                        for (int dh = 0; dh < 2; ++dh) { const LAS unsigned char* vp = lds + LB_V + (dh * 32 + l31) * VT_STRIDE + key0 * 2;
                            const u32x2 lo = *(const LAS u32x2*)vp, h2 = *(const LAS u32x2*)(vp + 16);
                            v4u vw; vw.x = lo.x; vw.y = lo.y; vw.z = h2.x; vw.w = h2.y;
                            O[dh] = __builtin_amdgcn_mfma_f32_32x32x16_bf16(pa, __builtin_bit_cast(bf16x8, vw), O[dh], 0, 0, 0); } }
            }
#pragma unroll
            for (int dh = 0; dh < 2; ++dh) {
                const int jcol = jb + dh * 32 + l31;
                const float ba_v = p.lru_ba[l * D + hb * 128 + jcol], bx_v = p.lru_bx[l * D + hb * 128 + jcol];
                const float kk_v = -8.0f * log1pf(__expf(-p.lru_lambda[l * D + hb * 128 + jcol]));
                f32x16 ra = (f32x16){}, ia = (f32x16){};
                const bf16* wap = waT + ((size_t)hb * 128 + jcol) * 128 + 8 * hi; const bf16* wxp = wxT + ((size_t)hb * 128 + jcol) * 128 + 8 * hi;
#pragma unroll
                for (int ks = 0; ks < 8; ++ks) { const bf16x8 af = *(const LAS bf16x8*)(lds + LB_XC + hbl * (32 * XC_STRIDE) + l31 * XC_STRIDE + (16 * ks + 8 * hi) * 2);
                    const bf16x8 bwa = *(const bf16x8*)(wap + 16 * ks), bwx = *(const bf16x8*)(wxp + 16 * ks);
                    ra = __builtin_amdgcn_mfma_f32_32x32x16_bf16(af, bwa, ra, 0, 0, 0); ia = __builtin_amdgcn_mfma_f32_32x32x16_bf16(af, bwx, ia, 0, 0, 0); }
                float av[16], bv[16];
                const LAS unsigned short* xcol = (const LAS unsigned short*)(lds + LB_XC + hbl * (32 * XC_STRIDE)) + jcol;
#pragma unroll
                for (int r = 0; r < 16; ++r) { const int tok = (r & 3) + 8 * (r >> 2) + 4 * hi;
                    const float rr = fast_sigmoid(ra[r] + ba_v), ii = fast_sigmoid(ia[r] + bx_v);
                    const float la = kk_v * rr;
                    const float a = __builtin_amdgcn_exp2f(la * LOG2E);
                    const float e2 = 2.0f * la;
                    const float om = (e2 > -0.1f) ? -e2 * (1.0f + e2 * (0.5f + e2 * (0.16666667f + e2 * 0.041666668f))) : 1.0f - a * a;
                    const float xc = bf2f(xcol[tok * (XC_STRIDE / 2)]);
                    av[r] = a; bv[r] = __builtin_sqrtf(om) * (ii * xc); }
                float Ag[4], Bg[4], Ap[4], Bp[4];
#pragma unroll
                for (int g = 0; g < 4; ++g) { float A = av[4 * g], B = bv[4 * g];
#pragma unroll
                    for (int e = 1; e < 4; ++e) { B = av[4 * g + e] * B + bv[4 * g + e]; A *= av[4 * g + e]; }
                    Ag[g] = A; Bg[g] = B; Ap[g] = __shfl_xor(A, 32); Bp[g] = __shfl_xor(B, 32); }
                float hs = hprev[dh], At = atot[dh], stt[4];
#pragma unroll
                for (int g = 0; g < 4; ++g) { const float A0 = hi ? Ap[g] : Ag[g], B0 = hi ? Bp[g] : Bg[g], A1 = hi ? Ag[g] : Ap[g], B1 = hi ? Bg[g] : Bp[g];
                    const float s0 = hs; hs = A0 * hs + B0; const float s1 = hs; hs = A1 * hs + B1; stt[g] = hi ? s1 : s0; At *= A0 * A1; }
                hprev[dh] = hs; atot[dh] = At;
                if (FINAL) {
                    const int col = hb * 128 + jcol;
#pragma unroll
                    for (int g = 0; g < 4; ++g) { float h = stt[g];
#pragma unroll
                        for (int e = 0; e < 4; ++e) { const int r = 4 * g + e; h = av[r] * h + bv[r];
                            const size_t trow = (size_t)(row0 + 32 * c + (r & 3) + 8 * (r >> 2) + 4 * hi);
                            const bf16* pr = P + trow * INW + col;
                            const float ga = bf2f(pr[C_GA]), gb = bf2f(pr[C_GB]), lg = bf2f(pr[C_LG]);
                            const float y = fast_sigmoid(ga) * O[dh][r] + fast_sigmoid(gb) * gelu_tanh_f(lg) * h;
                            Y[trow * D + col] = (bf16)f2bf(y); } }
                }
            }
        }
        if (!FINAL) {
#pragma unroll
            for (int dh = 0; dh < 2; ++dh) if (hi == 0) { const size_t o = ((size_t)b * 32 + n) * 1024 + hb * 128 + jb + dh * 32 + l31; SA[o] = atot[dh]; SB[o] = hprev[dh]; }
        }
    }
}

__device__ __forceinline__ void phase_ln1(const Ptrs& p, int l, LAS unsigned char* lds, int gw, int NGW, int tid, int lane) {
    LAS float* rwT = (LAS float*)lds;
    for (int i = tid; i < D * NE; i += 512) rwT[(i & 15) * D + (i >> 4)] = p.router_w[i];
    __syncthreads();
    const float* xin = (l == 0) ? p.x : p.out; float* xout = p.out;
    const bf16* Z = (const bf16*)(p.ws + WS_H); bf16* U = (bf16*)(p.ws + WS_U);
    const float* mod_l = (const float*)(p.ws + WS_MOD) + (size_t)l * NB * 6144;
    int* eidx = (int*)(p.ws + WS_EIDX); float* ew = (float*)(p.ws + WS_EW); int* list = (int*)(p.ws + WS_LIST);
    unsigned* cnt = (unsigned*)(p.ws + WS_CTL) + CW_CNT + l * 1024;
    const float* g = p.ln1_g + l * D; const float* bt = p.ln1_b + l * D;
    LAS int* lcnt = (LAS int*)(lds + 65536); LAS int* lbase = lcnt + 16; LAS int* wrec = lcnt + 32 + (tid >> 6) * 32;
    const int nIt = (T + NGW - 1) / NGW;
    for (int it0 = 0; it0 < nIt; it0 += 8) {
    if (tid < 16) lcnt[tid] = 0;
    __syncthreads();
#pragma unroll 1
    for (int kk = 0; kk < 8; ++kk) { const int row = gw + (it0 + kk) * NGW; if (row >= T) break;
        const float* m = mod_l + (size_t)(row / SEQ) * 6144;
        f32x4 v[4]; float s = 0.f;
#pragma unroll
        for (int j = 0; j < 4; ++j) { const int col = 4 * lane + 256 * j; const f32x4 xv = *(const f32x4*)(xin + (size_t)row * D + col), g1 = *(const f32x4*)(m + 2048 + col);
            const u32x2 zz = *(const u32x2*)(Z + (size_t)row * D + col);
            const f32x4 zf = (f32x4){bf2f(zz.x & 0xffffu), bf2f(zz.x >> 16), bf2f(zz.y & 0xffffu), bf2f(zz.y >> 16)};
            v[j] = xv * ALPHA + g1 * zf; s += (v[j][0] + v[j][1]) + (v[j][2] + v[j][3]); }
        const float mean = wave_sum(s) * (1.f / D); float q = 0.f;
#pragma unroll
        for (int j = 0; j < 4; ++j) { v[j] = v[j] - mean; q += (v[j][0] * v[j][0] + v[j][1] * v[j][1]) + (v[j][2] * v[j][2] + v[j][3] * v[j][3]); }
        const float rstd = 1.0f / sqrtf(wave_sum(q) * (1.f / D) + LN_EPS);
        float lg[16];
#pragma unroll
        for (int e = 0; e < 16; ++e) lg[e] = 0.f;
#pragma unroll
        for (int j = 0; j < 4; ++j) { const int col = 4 * lane + 256 * j; const f32x4 gm = *(const f32x4*)(g + col), be = *(const f32x4*)(bt + col);
            const f32x4 xn = v[j] * rstd * gm + be; *(f32x4*)(xout + (size_t)row * D + col) = xn;
            const f32x4 sc = *(const f32x4*)(m + 4096 + col), sh = *(const f32x4*)(m + 3072 + col); const f32x4 uu = xn * (sc + 1.0f) + sh;
            u32x2 o; o.x = pk2(uu[0], uu[1]); o.y = pk2(uu[2], uu[3]); *(u32x2*)(U + (size_t)row * D + col) = o;
#pragma unroll
            for (int e = 0; e < 16; ++e) { const f32x4 rw = *(const LAS f32x4*)(rwT + e * D + col); lg[e] += (uu[0] * rw[0] + uu[1] * rw[1]) + (uu[2] * rw[2] + uu[3] * rw[3]); }
            asm volatile("" ::: "memory"); }
#pragma unroll
        for (int e = 0; e < 16; ++e) lg[e] = wave_sum(lg[e]);
        float sc[16]; float mx = -INFINITY;
#pragma unroll
        for (int e = 0; e < 16; ++e) { sc[e] = lg[e] + p.router_b[e]; mx = fmaxf(mx, sc[e]); }
        float sum = 0.f;
#pragma unroll
        for (int e = 0; e < 16; ++e) { sc[e] = __expf(sc[e] - mx); sum += sc[e]; }
        const float isum = 1.0f / sum;
#pragma unroll
        for (int e = 0; e < 16; ++e) sc[e] *= isum;
        int gsel = 0, bi0 = 0, bi1 = 1; float best = -1.f, bw0 = 0.f, bw1 = 0.f;
#pragma unroll
        for (int gI = 0; gI < 4; ++gI) {
            int i0 = 0; float w0 = sc[gI * 4];
#pragma unroll
            for (int k = 1; k < 4; ++k) if (sc[gI * 4 + k] > w0) { w0 = sc[gI * 4 + k]; i0 = k; }
            int i1 = -1; float w1 = -1.f;
#pragma unroll
            for (int k = 0; k < 4; ++k) if (k != i0 && sc[gI * 4 + k] > w1) { w1 = sc[gI * 4 + k]; i1 = k; }
            const float gs = w0 + w1;
            if (gs > best) { best = gs; gsel = gI; bi0 = i0; bi1 = i1; bw0 = w0; bw1 = w1; }
        }
        if (lane == 0) {
            const float wsum = bw0 + bw1; const int e0 = gsel * 4 + bi0, e1 = gsel * 4 + bi1;
            eidx[row * 2 + 0] = e0; eidx[row * 2 + 1] = e1; ew[row * 2 + 0] = bw0 / wsum; ew[row * 2 + 1] = bw1 / wsum;
            wrec[kk * 4 + 0] = e0; wrec[kk * 4 + 1] = __hip_atomic_fetch_add(lcnt + e0, 1, __ATOMIC_RELAXED, __HIP_MEMORY_SCOPE_WORKGROUP);
            wrec[kk * 4 + 2] = e1; wrec[kk * 4 + 3] = __hip_atomic_fetch_add(lcnt + e1, 1, __ATOMIC_RELAXED, __HIP_MEMORY_SCOPE_WORKGROUP);
        }
    }
    __syncthreads();
    if (tid < 16) lbase[tid] = (int)__hip_atomic_fetch_add(cnt + 64 * tid, (unsigned)lcnt[tid], __ATOMIC_RELAXED, __HIP_MEMORY_SCOPE_AGENT);
    __syncthreads();
    if (lane < 8) { const int row = gw + (it0 + lane) * NGW;
        if (row < T) { const int e0 = wrec[lane * 4 + 0], r0 = wrec[lane * 4 + 1], e1 = wrec[lane * 4 + 2], r1 = wrec[lane * 4 + 3];
            list[e0 * 16384 + lbase[e0] + r0] = row * 2 + 0; list[e1 * 16384 + lbase[e1] + r1] = row * 2 + 1; } }
    __syncthreads();
    }
}
__device__ __forceinline__ void phase_ln2(const Ptrs& p, int l, int gw, int NGW, int lane) {
    float* x = p.out; const bf16* F0 = (const bf16*)(p.ws + WS_P); const bf16* F1 = F0 + (size_t)T * D; bf16* U = (bf16*)(p.ws + WS_U);
    const float* mod_l = (const float*)(p.ws + WS_MOD) + (size_t)l * NB * 6144; const float* mod_n = mod_l + NB * 6144;
    const float* ew = (const float*)(p.ws + WS_EW);
    const float* g = p.ln2_g + l * D; const float* bt = p.ln2_b + l * D;
    for (int row = gw; row < T; row += NGW) {
        const float* m = mod_l + (size_t)(row / SEQ) * 6144; const float* mn = mod_n + (size_t)(row / SEQ) * 6144;
        const float wv = ew[row * 2 + (lane & 1)]; const float w0 = __shfl(wv, 0), w1 = __shfl(wv, 1);
        f32x4 v[4]; float s = 0.f;
#pragma unroll
        for (int j = 0; j < 4; ++j) { const int col = 4 * lane + 256 * j; const f32x4 xv = *(const f32x4*)(x + (size_t)row * D + col), g2 = *(const f32x4*)(m + 5120 + col);
            const u32x2 a = *(const u32x2*)(F0 + (size_t)row * D + col), c2 = *(const u32x2*)(F1 + (size_t)row * D + col);
            const f32x4 f = (f32x4){bf2f(a.x & 0xffffu), bf2f(a.x >> 16), bf2f(a.y & 0xffffu), bf2f(a.y >> 16)} * w0 + (f32x4){bf2f(c2.x & 0xffffu), bf2f(c2.x >> 16), bf2f(c2.y & 0xffffu), bf2f(c2.y >> 16)} * w1;
            v[j] = xv * ALPHA + g2 * f; s += (v[j][0] + v[j][1]) + (v[j][2] + v[j][3]); }
        const float mean = wave_sum(s) * (1.f / D); float q = 0.f;
#pragma unroll
        for (int j = 0; j < 4; ++j) { v[j] = v[j] - mean; q += (v[j][0] * v[j][0] + v[j][1] * v[j][1]) + (v[j][2] * v[j][2] + v[j][3] * v[j][3]); }
        const float rstd = 1.0f / sqrtf(wave_sum(q) * (1.f / D) + LN_EPS);
#pragma unroll
        for (int j = 0; j < 4; ++j) { const int col = 4 * lane + 256 * j; const f32x4 gm = *(const f32x4*)(g + col), be = *(const f32x4*)(bt + col);
            const f32x4 xn = v[j] * rstd * gm + be; *(f32x4*)(x + (size_t)row * D + col) = xn;
            if (l + 1 < NL) { const f32x4 sh = *(const f32x4*)(mn + col), sc = *(const f32x4*)(mn + 1024 + col); const f32x4 uu = xn * (sc + 1.0f) + sh;
                u32x2 o; o.x = pk2(uu[0], uu[1]); o.y = pk2(uu[2], uu[3]); *(u32x2*)(U + (size_t)row * D + col) = o; } }
    }
}
constexpr int N_PHASES = 2 + 8 * NL;
#ifndef REP_A
#define REP_A 1
#endif
#ifndef REP_B1
#define REP_B1 1
#endif
#ifndef REP_B2
#define REP_B2 1
#endif
#ifndef REP_C
#define REP_C 1
#endif
#ifndef REP_D
#define REP_D 1
#endif
#ifndef REP_E
#define REP_E 1
#endif
#ifndef REP_P0
#define REP_P0 1
#endif
struct Args { const float* in[24]; float* out; unsigned char* ws; int ph_lo, ph_hi; };
__global__ void __launch_bounds__(NWAVES * 64, 2) fwd(Args args) {
    extern __shared__ __attribute__((aligned(16))) unsigned char lds_raw[];
    LAS unsigned char* lds = (LAS unsigned char*)lds_raw;
    const int tid = threadIdx.x, lane = tid & 63, wave = __builtin_amdgcn_readfirstlane(tid >> 6);
    const int G = gridDim.x, bx = blockIdx.x, vcu = (G % 8 == 0) ? (bx % 8) * (G / 8) + bx / 8 : bx;
    const int gw = vcu * NWAVES + wave, NGW = G * NWAVES;
    Ptrs p;
    p.x = args.in[0]; p.c = args.in[1]; p.ada_w = args.in[2]; p.ada_b = args.in[3]; p.w_in = args.in[4]; p.attn_sink = args.in[5]; p.rel_bias = args.in[6]; p.conv_w = args.in[7]; p.conv_b = args.in[8];
    p.lru_wa = args.in[9]; p.lru_ba = args.in[10]; p.lru_wx = args.in[11]; p.lru_bx = args.in[12]; p.lru_lambda = args.in[13]; p.w_out = args.in[14]; p.ln1_g = args.in[15]; p.ln1_b = args.in[16];
    p.router_w = args.in[17]; p.router_b = args.in[18]; p.moe_wg = args.in[19]; p.moe_wu = args.in[20]; p.moe_wd = args.in[21]; p.ln2_g = args.in[22]; p.ln2_b = args.in[23];
    p.out = args.out; p.ws = args.ws;
    LAS unsigned* ctlw = (LAS unsigned*)(lds + LDSCTL_OFF);
    for (int u = tid; u < 256; u += NWAVES * 64) ctlw[u] = 0u;
    __syncthreads();
    const int lo = args.ph_lo, hi = args.ph_hi;
    XcdBarrier bar; bar.bar = (unsigned*)(p.ws + WS_CTL) + CW_BAR; bar.x = 0; bar.st = nullptr;
    if (hi - lo > 1) bar = xcd_barrier_post((unsigned*)(p.ws + WS_CTL) + CW_BAR, (volatile LAS unsigned*)(ctlw + 16));
#define IN(k) (lo <= (k) && (k) < hi)
#define LAUNDER_TID() int tidp = threadIdx.x; asm volatile("" : "+v"(tidp)); const int lanep = tidp & 63, wavep = __builtin_amdgcn_readfirstlane(tidp >> 6), gwp = vcu * NWAVES + wavep; (void)lanep; (void)gwp
#define SEAM(k) do { if (IN(k) && IN((k) + 1)) xcd_barrier(bar); } while (0)
    bf16* U = (bf16*)(p.ws + WS_U); bf16* Pb = (bf16*)(p.ws + WS_P); bf16* Yb = (bf16*)(p.ws + WS_Y); bf16* Hb = (bf16*)(p.ws + WS_H);
    const float* mod = (const float*)(p.ws + WS_MOD);

    for (int rep_ = 0; rep_ < REP_P0; ++rep_) {
        if (IN(0)) { LAUNDER_TID(); if (bx < NL * 24) mod_item(p, bx, lds, tidp, wavep, lanep); convert_layer(p, 0, lds, gwp, NGW, wavep, lanep); }
    SEAM(0); }

    if (IN(1)) { LAUNDER_TID(); modulate_rows(p.x, mod, U, gwp, NGW, lanep); }
    SEAM(1);
#pragma unroll 1
    for (int l = 0; l < NL; ++l) {
        const int pb = 2 + 8 * l;
        for (int rep_ = 0; rep_ < REP_A; ++rep_) {
        if (IN(pb + 0)) { LAUNDER_TID(); pg8::Gemm g{U, (const bf16*)(p.ws + WS_WIN), T, INW, D}; pg8::StaticOrder S; S.init(T, INW, G, bx); pg8::EpiStoreBf16 E{Pb, INW};
            pg8::gemm_phase<pg8::EpiStoreBf16, pg8::StaticOrder, true, false>(lds + RING_OFF, g, S, E, tidp); }
        SEAM(pb + 0); }

        for (int rep_ = 0; rep_ < REP_B1; ++rep_) {
        if (IN(pb + 1)) phase_b<false>(p, l, lds, vcu, G);
        SEAM(pb + 1); }

        for (int rep_ = 0; rep_ < REP_B2; ++rep_) {
        if (IN(pb + 2)) phase_b<true>(p, l, lds, vcu, G);
        SEAM(pb + 2); }

        for (int rep_ = 0; rep_ < REP_C; ++rep_) {
        if (IN(pb + 3)) { LAUNDER_TID(); pg8::Gemm g{Yb, (const bf16*)(p.ws + WS_WO), T, D, D}; pg8::StaticOrder S; S.init(T, D, G, bx); pg8::EpiStoreBf16 E{Hb, D};
            pg8::gemm_phase<pg8::EpiStoreBf16, pg8::StaticOrder, false, false>(lds + RING_OFF, g, S, E, tidp); }
        SEAM(pb + 3); }

        if (IN(pb + 4)) { LAUNDER_TID(); phase_ln1(p, l, lds, gwp, NGW, tidp, lanep); }
        SEAM(pb + 4);
        for (int rep_ = 0; rep_ < REP_D; ++rep_) {
        if (IN(pb + 5)) { LAUNDER_TID();
            if (tidp < 16) ((LAS int*)ctlw)[tidp] = (int)__hip_atomic_load((unsigned*)(p.ws + WS_CTL) + CW_CNT + l * 1024 + 64 * tidp, __ATOMIC_RELAXED, __HIP_MEMORY_SCOPE_AGENT);
            __syncthreads();
            pg8::Gemm g{U, (const bf16*)(p.ws + WS_WGU), T, NE * 1024, D}; pg8::MoeOrder S{(const LAS int*)ctlw, (const int*)(p.ws + WS_LIST), G, vcu}; pg8::EpiMoeGU E{Hb};
            pg8::gemm_phase<pg8::EpiMoeGU, pg8::MoeOrder, true, true>(lds + RING_OFF, g, S, E, tidp); }
        SEAM(pb + 5); }

        for (int rep_ = 0; rep_ < REP_E; ++rep_) {
        if (IN(pb + 6)) { LAUNDER_TID();
            if (tidp < 16) ((LAS int*)ctlw)[tidp] = (int)__hip_atomic_load((unsigned*)(p.ws + WS_CTL) + CW_CNT + l * 1024 + 64 * tidp, __ATOMIC_RELAXED, __HIP_MEMORY_SCOPE_AGENT);
            __syncthreads();
            pg8::Gemm g{Hb, (const bf16*)(p.ws + WS_WD), 36864, NE * 1024, FF}; pg8::MoeOrder S{(const LAS int*)ctlw, (const int*)(p.ws + WS_LIST), G, vcu}; pg8::EpiMoeDown E{Pb, (const int*)(p.ws + WS_LIST), T};
            pg8::gemm_phase<pg8::EpiMoeDown, pg8::MoeOrder, true, false>(lds + RING_OFF, g, S, E, tidp); }
        SEAM(pb + 6); }

        if (IN(pb + 7)) { LAUNDER_TID(); phase_ln2(p, l, gwp, NGW, lanep); if (l + 1 < NL) convert_layer(p, l + 1, lds, gwp, NGW, wavep, lanep); }
        SEAM(pb + 7);
    }
#undef IN
#undef SEAM
}
#ifndef MK_SPLIT
#define MK_SPLIT 0
#endif
extern "C" void kernel_launch(void* const* d_in, const int* in_sizes, int n_in, void* d_out, int out_size, void* d_ws, size_t ws_size, hipStream_t stream) {
    static int grid = 0;
    if (grid == 0) {
        if (n_in != 24 || in_sizes[0] != T * D || out_size != T * D || ws_size < WS_END) { fprintf(stderr, "kernel_launch: unexpected shapes (n_in %d, in0 %d, out %d, ws %zu); nothing launched\n", n_in, n_in > 0 ? in_sizes[0] : -1, out_size, ws_size); grid = -1; return; }
        int dev = 0, cus = 0, per_cu = 0;
        if (hipGetDevice(&dev) != hipSuccess || hipDeviceGetAttribute(&cus, hipDeviceAttributeMultiprocessorCount, dev) != hipSuccess) { fprintf(stderr, "kernel_launch: device query failed\n"); grid = -1; return; }
        if (hipFuncSetAttribute((const void*)fwd, hipFuncAttributeMaxDynamicSharedMemorySize, LDS_BYTES) != hipSuccess) { fprintf(stderr, "kernel_launch: hipFuncSetAttribute failed\n"); grid = -1; return; }
        if (hipOccupancyMaxActiveBlocksPerMultiprocessor(&per_cu, (const void*)fwd, NWAVES * 64, LDS_BYTES) != hipSuccess || per_cu < 1) fprintf(stderr, "kernel_launch: occupancy query reports %d blocks per CU\n", per_cu);
        (void)hipGetLastError();
        grid = cus;
    }
    if (grid < 0) return;
    if (hipMemsetAsync((char*)d_ws + WS_CTL, 0, CTL_ZERO_BYTES, stream) != hipSuccess) { fprintf(stderr, "kernel_launch: memset failed\n"); return; }
    Args a{};
    for (int i = 0; i < 24; ++i) a.in[i] = (const float*)d_in[i];
    a.out = (float*)d_out; a.ws = (unsigned char*)d_ws;
#if MK_SPLIT
    for (int ph = 0; ph < N_PHASES; ++ph) { a.ph_lo = ph; a.ph_hi = ph + 1; hipLaunchKernelGGL(fwd, dim3(grid), dim3(NWAVES * 64), LDS_BYTES, stream, a); }
#else
    a.ph_lo = 0; a.ph_hi = N_PHASES; hipLaunchKernelGGL(fwd, dim3(grid), dim3(NWAVES * 64), LDS_BYTES, stream, a);
#endif
    const hipError_t le = hipPeekAtLastError();
    if (le != hipSuccess) fprintf(stderr, "kernel_launch: launch failed: %s\n", hipGetErrorName(le));
}
```

```cpp
#include <hip/hip_runtime.h>
#include <cstdio>
#include <cstdint>
#define MK_SPLIT 0
namespace pg8 {
#define PG8_LAS __attribute__((address_space(3)))
typedef unsigned short bf16_t;
typedef short bf16x8 __attribute__((ext_vector_type(8)));
typedef float f32x4 __attribute__((ext_vector_type(4)));
typedef unsigned u32x4 __attribute__((ext_vector_type(4)));
constexpr int BM = 256, BK = 64, HALF = 128, HTB = HALF * BK * 2  , STAGE_BYTES = 8 * HTB, NXCD = 8, WGM = 8;

__host__ __device__ __forceinline__ int lds_byte(int r, int c) { const int st = (r >> 4) * 2 + (c >> 5), rr = r & 15, cc = c & 31, ob = rr * 64 + cc * 2; return st * 1024 + (ob ^ (((ob >> 9) & 1) << 5)); }
__host__ __device__ __forceinline__ void stage_rc(int b, int& R, int& C) { const int st = b / 1024, sb = b % 1024, swz = sb ^ (((sb >> 9) & 1) << 5); R = (st >> 1) * 16 + swz / 64; C = (st & 1) * 32 + (swz % 64) / 2; }
__host__ __device__ __forceinline__ int perm32(int rho) { const int n = rho >> 4, i = rho & 15; return 8 * (i >> 2) + 4 * n + (i & 3); }

struct Unit { int pm, pn, e, mt, nv; };
struct Gemm { const bf16_t* A; const bf16_t* Bt; int M, N, K; };

struct StaticOrder {
    int nM, nN, nwg, G, c;
    __host__ __device__ void init(int M, int N, int G_, int c_) { nM = M / BM; nN = N / BM; nwg = nM * nN; G = G_; c = c_; }
    __host__ __device__ bool next(int i, Unit& u) const {
        const long L = (long)i * G + c; if (L >= nwg) return false;
        int wgid = (int)L; { const int q = nwg / NXCD, r = nwg % NXCD, xcd = wgid % NXCD, off = wgid / NXCD; wgid = (xcd < r ? xcd * (q + 1) : r * (q + 1) + (xcd - r) * q) + off; }
        const int nig = WGM * nN, gid = wgid / nig, fm = gid * WGM, gsz = (nM - fm) < WGM ? (nM - fm) : WGM;
        u.pm = fm + ((wgid % nig) % gsz); u.pn = (wgid % nig) / gsz; u.e = 0; u.mt = 0; u.nv = 256; return true;
    }
    __device__ __forceinline__ void a_ready(const Unit&) const {}
    __device__ __forceinline__ void done(const Unit&) const {}
};

__device__ __forceinline__ unsigned cvt_pk_bf16(float lo, float hi) { unsigned r; asm volatile("v_cvt_pk_bf16_f32 %0, %1, %2" : "=v"(r) : "v"(lo), "v"(hi)); return r; }
typedef float f32x2 __attribute__((ext_vector_type(2)));
__device__ __forceinline__ f32x2 gelu_pk(f32x2 v) {
    const f32x2 av = __builtin_elementwise_abs(v), d = av * 0.2316418882f + 1.0f;
    f32x2 t; t.x = __builtin_amdgcn_rcpf(d.x); t.y = __builtin_amdgcn_rcpf(d.y);
    f32x2 q = t * 0.5307027145f + (-0.7265760135f); q = q * t + 0.7107068705f; q = q * t + (-0.142248368f); q = q * t + 0.127414796f; q = q * t;
    const f32x2 s = (v * v) * (-0.72134752044f);
    f32x2 e; e.x = __builtin_amdgcn_exp2f(s.x); e.y = __builtin_amdgcn_exp2f(s.y);
    const f32x2 m = v * (q * e), r = v - m;
    f32x2 o; o.x = v.x < 0.f ? m.x : r.x; o.y = v.y < 0.f ? m.y : r.y; return o;
}

struct EpiStoreBf16 {
    static constexpr bool PERM = true, AFTER_DRAIN = false;
    bf16_t* O; int ldc;
    __device__ __forceinline__ void operator()(const f32x4 (&acc)[2][2][4][2], const Unit& u, int wr, int wc, int fr, int fq) const {
        const int row0 = u.pm * BM + wr * 64 + fr, col0 = u.pn * BM + wc * 32 + 8 * fq;
#pragma unroll
        for (int ai = 0; ai < 2; ++ai)
#pragma unroll
            for (int m = 0; m < 4; ++m) { bf16_t* rowp = O + (size_t)(row0 + ai * HALF + m * 16) * ldc + col0;
#pragma unroll
                for (int bj = 0; bj < 2; ++bj) { const f32x4 v0 = acc[ai][bj][m][0], v1 = acc[ai][bj][m][1];
                    u32x4 w; w.x = cvt_pk_bf16(v0[0], v0[1]); w.y = cvt_pk_bf16(v0[2], v0[3]); w.z = cvt_pk_bf16(v1[0], v1[1]); w.w = cvt_pk_bf16(v1[2], v1[3]);
                    *(u32x4*)(rowp + bj * HALF) = w; } }
    }
};
__device__ __forceinline__ float silu_f(float x) { return x * __builtin_amdgcn_rcpf(1.0f + __builtin_amdgcn_exp2f(-1.4426950408889634f * x)); }
struct EpiMoeGU {
    static constexpr bool PERM = true, AFTER_DRAIN = false;
    bf16_t* H;
    __device__ __forceinline__ void operator()(const f32x4 (&acc)[2][2][4][2], const Unit& u, int wr, int wc, int fr, int fq) const {
        const int row0 = u.pm * BM + wr * 64 + fr, hc0 = (u.pn & 3) * 128 + wc * 32 + 8 * fq;
#pragma unroll
        for (int ai = 0; ai < 2; ++ai)
#pragma unroll
            for (int m = 0; m < 4; ++m) { bf16_t* rowp = H + (size_t)(row0 + ai * HALF + m * 16) * 512 + hc0;
                const f32x4 g0 = acc[ai][0][m][0], g1 = acc[ai][0][m][1], u0 = acc[ai][1][m][0], u1 = acc[ai][1][m][1];
                u32x4 w; w.x = cvt_pk_bf16(silu_f(g0[0]) * u0[0], silu_f(g0[1]) * u0[1]); w.y = cvt_pk_bf16(silu_f(g0[2]) * u0[2], silu_f(g0[3]) * u0[3]);
                w.z = cvt_pk_bf16(silu_f(g1[0]) * u1[0], silu_f(g1[1]) * u1[1]); w.w = cvt_pk_bf16(silu_f(g1[2]) * u1[2], silu_f(g1[3]) * u1[3]);
                *(u32x4*)rowp = w; }
    }
};
struct EpiMoeDown {
    static constexpr bool PERM = true, AFTER_DRAIN = false;
    bf16_t* F; const int* list; int T;
    __device__ __forceinline__ void operator()(const f32x4 (&acc)[2][2][4][2], const Unit& u, int wr, int wc, int fr, int fq) const {
        const int* lb = list + u.e * 16384 + u.mt * BM; const int col0 = (u.pn & 3) * BM + wc * 32 + 8 * fq;
#pragma unroll
        for (int ai = 0; ai < 2; ++ai)
#pragma unroll
            for (int m = 0; m < 4; ++m) { const int rl = ai * HALF + wr * 64 + m * 16 + fr;
                if (rl < u.nv) { const int ent = lb[rl]; bf16_t* rowp = F + ((size_t)(ent & 1) * T + (ent >> 1)) * 1024 + col0;
#pragma unroll
                    for (int bj = 0; bj < 2; ++bj) { const f32x4 v0 = acc[ai][bj][m][0], v1 = acc[ai][bj][m][1];
                        u32x4 w; w.x = cvt_pk_bf16(v0[0], v0[1]); w.y = cvt_pk_bf16(v0[2], v0[3]); w.z = cvt_pk_bf16(v1[0], v1[1]); w.w = cvt_pk_bf16(v1[2], v1[3]);
                        *(u32x4*)(rowp + bj * HALF) = w; } } }
    }
};
struct MoeOrder {
    const PG8_LAS int* cntl; const int* list; int G, c;
    __device__ __forceinline__ bool next(int i, Unit& u) const {
        const int L = i * G + c, tile = L >> 2; int acc = 0;
#pragma unroll 1
        for (int e = 0; e < 16; ++e) { const int ce = cntl[e], nte = (ce + BM - 1) >> 8;
            if (tile < acc + nte) { u.e = e; u.mt = tile - acc; u.pm = tile; u.pn = e * 4 + (L & 3); const int rem = ce - u.mt * BM; u.nv = rem < BM ? rem : BM; return true; }
            acc += nte; }
        return false;
    }
    __device__ __forceinline__ int gather_row(const Unit& u, int r) const { const int* lb = list + u.e * 16384 + u.mt * BM; return lb[r < u.nv ? r : 0] >> 1; }
    __device__ __forceinline__ void a_ready(const Unit&) const {}
    __device__ __forceinline__ void done(const Unit&) const {}
};

template <class Epi, class Sched, bool ALIGN_EPI, bool GATHER>
__device__ __forceinline__ void gemm_phase(PG8_LAS unsigned char* lds, const Gemm g, const Sched& S, const Epi& E, const int tid) {
    const int wid = __builtin_amdgcn_readfirstlane(tid >> 6), lane = tid & 63, wr = wid >> 2, wc = wid & 3, fr = lane & 15, fq = lane >> 4;
    const int K = g.K, nt = K / BK;
    unsigned voffB[2], vC[2][2], vN[2][2]; int stR[2], stC[2];
#pragma unroll
    for (int i = 0; i < 2; ++i) { int R, C; stage_rc(tid * 16 + i * 8192, R, C); stR[i] = R; stC[i] = C; const int Rb = Epi::PERM ? ((R & ~31) + perm32(R & 31)) : R;
        voffB[i] = (unsigned)(Rb * K + C) * 2u; }
    const size_t kstep = (size_t)(BK * 2);
    const size_t hstep = (size_t)HALF * K * 2;
    const size_t tstep = 2 * hstep;
    const unsigned ldsw = (unsigned)wid * 1024u;
    const int aoff = lds_byte(wr * 64 + fr, fq * 8), boff = lds_byte(wc * 32 + fr, fq * 8);
#define PG8_SA(b, h) (((b) * 2 + (h)) * HTB)
#define PG8_SB(b, h) ((4 + (b) * 2 + (h)) * HTB)
#define PG8_STAGE(bufoff, gbase, voff) do { _Pragma("unroll") for (int _i = 0; _i < 2; ++_i) \
        __builtin_amdgcn_global_load_lds((const unsigned*)((const char*)(gbase) + (voff)[_i]), (PG8_LAS unsigned*)(lds + (bufoff) + ldsw + _i * 8192), 16, 0, 0); } while (0)
#define PG8_LDA(dst, b, h) do { _Pragma("unroll") for (int m = 0; m < 4; ++m) _Pragma("unroll") for (int k = 0; k < 2; ++k) dst[m][k] = *(const PG8_LAS bf16x8*)(lds + PG8_SA(b, h) + aoff + m * 2048 + k * 1024); } while (0)
#define PG8_LDB(dst, b, h) do { _Pragma("unroll") for (int n = 0; n < 2; ++n) _Pragma("unroll") for (int k = 0; k < 2; ++k) dst[n][k] = *(const PG8_LAS bf16x8*)(lds + PG8_SB(b, h) + boff + n * 2048 + k * 1024); } while (0)
#define PG8_MMA(ai, bj, At, Bt) do { __builtin_amdgcn_s_setprio(1); _Pragma("unroll") for (int m = 0; m < 4; ++m) _Pragma("unroll") for (int n = 0; n < 2; ++n) _Pragma("unroll") for (int k = 0; k < 2; ++k) \
        acc[ai][bj][m][n] = __builtin_amdgcn_mfma_f32_16x16x32_bf16(Bt[n][k], At[m][k], acc[ai][bj][m][n], 0, 0, 0); __builtin_amdgcn_s_setprio(0); } while (0)
#define PG8_WAIT_V(n) asm volatile("s_waitcnt vmcnt(" #n ")" ::: "memory")
#define PG8_WAIT_L(n) asm volatile("s_waitcnt lgkmcnt(" #n ")" ::: "memory")
#define PG8_BAR __builtin_amdgcn_s_barrier()
#define PG8_SCHED __builtin_amdgcn_sched_barrier(0)
#define PG8_SETV(v, u) do { _Pragma("unroll") for (int _h = 0; _h < 2; ++_h) _Pragma("unroll") for (int _i = 0; _i < 2; ++_i) { \
        if constexpr (GATHER) { const int _tok = S.gather_row(u, _h * HALF + stR[_i]); v[_h][_i] = (unsigned)(_tok * K + stC[_i]) * 2u; } \
        else v[_h][_i] = (unsigned)((_h * HALF + stR[_i]) * K + stC[_i]) * 2u; } } while (0)
#define PG8_STAGE_SEL(bufoff, gbase, h) do { _Pragma("unroll") for (int _i = 0; _i < 2; ++_i) { const unsigned _o = (GATHER && last) ? vN[h][_i] : vC[h][_i]; \
        __builtin_amdgcn_global_load_lds((const unsigned*)((const char*)(gbase) + _o), (PG8_LAS unsigned*)(lds + (bufoff) + ldsw + _i * 8192), 16, 0, 0); } } while (0)
    Unit cur, nxt; int ui = 0;
    if (!S.next(0, cur)) return;
    f32x4 acc[2][2][4][2];
#pragma unroll
    for (int a = 0; a < 2; ++a)
#pragma unroll
        for (int b = 0; b < 2; ++b)
#pragma unroll
            for (int m = 0; m < 4; ++m)
#pragma unroll
                for (int n = 0; n < 2; ++n) acc[a][b][m][n] = (f32x4){0.f, 0.f, 0.f, 0.f};
    bf16x8 At[4][2], B0[2][2], B1[2][2];
    PG8_SETV(vC, cur);
    if constexpr (GATHER) asm volatile("s_waitcnt vmcnt(0)" : "+v"(vC[0][0]), "+v"(vC[0][1]), "+v"(vC[1][0]), "+v"(vC[1][1]) :: "memory");
    const char* cA = GATHER ? (const char*)g.A : (const char*)g.A + (size_t)cur.pm * tstep; const char* cB = (const char*)g.Bt + (size_t)cur.pn * tstep;
    S.a_ready(cur);
    PG8_STAGE(PG8_SB(0, 0), cB, voffB); PG8_STAGE(PG8_SB(0, 1), cB + hstep, voffB); PG8_STAGE(PG8_SA(0, 0), cA, vC[0]); PG8_STAGE(PG8_SA(0, 1), cA, vC[1]);
    if (wr == 1) PG8_BAR;
    PG8_WAIT_V(2); PG8_BAR;
    PG8_STAGE(PG8_SB(1, 0), cB + kstep, voffB); PG8_STAGE(PG8_SA(1, 0), cA + kstep, vC[0]); PG8_STAGE(PG8_SB(1, 1), cB + hstep + kstep, voffB);
    PG8_WAIT_V(6); PG8_BAR;
    for (;;) {
        const bool has_next = S.next(ui + 1, nxt);
        if constexpr (GATHER) {
            if (has_next) { PG8_SETV(vN, nxt); asm volatile("s_waitcnt vmcnt(0)" : "+v"(vN[0][0]), "+v"(vN[0][1]), "+v"(vN[1][0]), "+v"(vN[1][1]) :: "memory"); }
            else {
#pragma unroll
                for (int h = 0; h < 2; ++h)
#pragma unroll
                    for (int i = 0; i < 2; ++i) vN[h][i] = vC[h][i]; }
        }
        const char* nA = GATHER ? cA : (has_next ? (const char*)g.A + (size_t)nxt.pm * tstep : cA); const char* nB = has_next ? (const char*)g.Bt + (size_t)nxt.pn * tstep : cB;
        for (int t = 0; t < nt; t += 2) {
            const bool last = (t == nt - 2);
            const char* a1 = cA + (size_t)(t + 1) * kstep;
            const char* a2 = last ? nA : cA + (size_t)(t + 2) * kstep; const char* b2 = last ? nB : cB + (size_t)(t + 2) * kstep;
            const char* a3 = a2 + kstep; const char* b3 = b2 + kstep;
            if (last && has_next) S.a_ready(nxt);
            PG8_LDB(B0, 0, 0); PG8_LDB(B1, 0, 1); PG8_SCHED; PG8_LDA(At, 0, 0); PG8_STAGE(PG8_SA(1, 1), a1, vC[1]);
            PG8_WAIT_V(8); PG8_WAIT_L(0); PG8_BAR; PG8_MMA(0, 0, At, B0); PG8_MMA(0, 1, At, B1); PG8_BAR; PG8_SCHED;
            PG8_LDA(At, 0, 1); PG8_STAGE(PG8_SB(0, 0), b2, voffB); PG8_STAGE(PG8_SB(0, 1), b2 + hstep, voffB); PG8_STAGE_SEL(PG8_SA(0, 0), a2, 0);
            PG8_WAIT_V(8); PG8_WAIT_L(0); PG8_BAR; PG8_MMA(1, 0, At, B0); PG8_MMA(1, 1, At, B1); PG8_BAR; PG8_SCHED;
            PG8_LDB(B0, 1, 0); PG8_LDB(B1, 1, 1); PG8_SCHED; PG8_LDA(At, 1, 0); PG8_STAGE_SEL(PG8_SA(0, 1), a2, 1);
            PG8_WAIT_V(8); PG8_WAIT_L(0); PG8_BAR; PG8_MMA(0, 0, At, B0); PG8_MMA(0, 1, At, B1); PG8_BAR; PG8_SCHED;
            PG8_LDA(At, 1, 1); PG8_STAGE(PG8_SB(1, 0), b3, voffB); PG8_STAGE(PG8_SB(1, 1), b3 + hstep, voffB); PG8_STAGE_SEL(PG8_SA(1, 0), a3, 0);
            PG8_WAIT_V(8); PG8_WAIT_L(0); PG8_BAR; PG8_MMA(1, 0, At, B0); PG8_MMA(1, 1, At, B1); PG8_BAR; PG8_SCHED;
        }
        if constexpr (ALIGN_EPI) { if (wr == 0) PG8_BAR; }
        E(acc, cur, wr, wc, fr, fq); S.done(cur);
        if (!has_next) break;
#pragma unroll
        for (int a = 0; a < 2; ++a)
#pragma unroll
            for (int b = 0; b < 2; ++b)
#pragma unroll
                for (int m = 0; m < 4; ++m)
#pragma unroll
                    for (int n = 0; n < 2; ++n) acc[a][b][m][n] = (f32x4){0.f, 0.f, 0.f, 0.f};
        cur = nxt; cA = nA; cB = nB; ++ui;
        if constexpr (GATHER) {
#pragma unroll
            for (int h = 0; h < 2; ++h)
#pragma unroll
                for (int i = 0; i < 2; ++i) vC[h][i] = vN[h][i]; }
        if constexpr (ALIGN_EPI) { if (wr == 1) PG8_BAR; }
    }
    PG8_WAIT_V(0);
    if constexpr (!ALIGN_EPI) { if (wr == 0) PG8_BAR; }
    PG8_BAR;
#undef PG8_SA
#undef PG8_SB
#undef PG8_STAGE
#undef PG8_LDA
#undef PG8_LDB
#undef PG8_MMA
#undef PG8_WAIT_V
#undef PG8_WAIT_L
#undef PG8_BAR
#undef PG8_SCHED
#undef PG8_SETV
#undef PG8_STAGE_SEL
}
}
#define GAS __attribute__((address_space(1)))
#define LAS __attribute__((address_space(3)))
typedef unsigned short bf16;
typedef unsigned v4u __attribute__((ext_vector_type(4)));
typedef float f32x4 __attribute__((ext_vector_type(4)));
typedef short bf16x8 __attribute__((ext_vector_type(8)));
typedef GAS unsigned gu32;
typedef GAS unsigned long long gu64;
#define RLX_AGENT __ATOMIC_RELAXED, __HIP_MEMORY_SCOPE_AGENT
#define LDS_WAIT() asm volatile("s_waitcnt lgkmcnt(0)" ::: "memory")
#define VM_WAIT() asm volatile("s_waitcnt vmcnt(0)" ::: "memory")
__device__ __forceinline__ unsigned long long rt() { return __builtin_amdgcn_s_memrealtime(); }
__device__ __forceinline__ unsigned f2bf(float f) { unsigned u = __builtin_bit_cast(unsigned, f); return (u + 0x7fffu + ((u >> 16) & 1u)) >> 16; }
__device__ __forceinline__ unsigned pk2(float lo, float hi) { return f2bf(lo) | (f2bf(hi) << 16); }

#define XB_TMO      128
#define XB_XCNT(j)  (256  + 64 * (j))
#define XB_XSUB(j)  (1280 + 64 * (j))
#define XB_XGEN(j)  (2304 + 64 * (j))
#define XB_TOP      3328
#define XB_TOPGEN   3392
#define XCD_BAR_WORDS 3456
#define XB_SPIN_CAP (1u << 18)

__device__ __forceinline__ unsigned xb_ld(unsigned* p)              { return __hip_atomic_load(p, __ATOMIC_RELAXED, __HIP_MEMORY_SCOPE_AGENT); }
__device__ __forceinline__ unsigned xb_add(unsigned* p, unsigned v) { return __hip_atomic_fetch_add(p, v, __ATOMIC_RELAXED, __HIP_MEMORY_SCOPE_AGENT); }
__device__ __forceinline__ unsigned xb_xcc_id() { return (unsigned)__builtin_amdgcn_s_getreg((3 << 11) | 20) & 0xFu; }
#define XB_SPIN(cond, bar) do { unsigned _sp = 0; while (cond) { __builtin_amdgcn_s_sleep(1); \
    if ((++_sp & 255u) == 0u) { if (xb_ld(&(bar)[XB_TMO])) break; if (_sp > XB_SPIN_CAP) { atomicAdd(&(bar)[XB_TMO], 1u); break; } } } } while (0)

struct XcdBarrier {
    unsigned* bar; unsigned x;
    volatile LAS unsigned* st;
};

__device__ __forceinline__ XcdBarrier xcd_barrier_post(unsigned* bar, volatile LAS unsigned* st) {
    XcdBarrier b; b.bar = bar; b.x = xb_xcc_id(); b.st = st;
    if (threadIdx.x == 0) (void)xb_add(&bar[XB_XCNT(b.x)], 1u);
    return b;
}
__device__ __forceinline__ void xcd_barrier_complete(unsigned* bar, unsigned x, unsigned& nloc, unsigned& nx) {
    const unsigned G = gridDim.x * gridDim.y * gridDim.z;
    unsigned sum, cnt, mine, sp = 0u;
    for (;;) {
        sum = 0u; cnt = 0u; mine = 0u;
#pragma unroll
        for (unsigned j = 0; j < 16; ++j) { const unsigned c = xb_ld(&bar[XB_XCNT(j)]); sum += c; cnt += (c > 0u) ? 1u : 0u; mine = (j == x) ? c : mine; }
        if (sum == G) break;
        __builtin_amdgcn_s_sleep(1);
        if ((++sp & 255u) == 0u) { if (xb_ld(&bar[XB_TMO])) break; if (sp > XB_SPIN_CAP) { atomicAdd(&bar[XB_TMO], 1u); break; } }
    }
    nloc = mine > 0u ? mine : 1u; nx = cnt > 0u ? cnt : 1u;
}

__device__ __forceinline__ void xcd_barrier(const XcdBarrier& b) {
    asm volatile("s_waitcnt vmcnt(0)" ::: "memory");
    __syncthreads();
    if (threadIdx.x == 0) {
        unsigned* bar = b.bar;
        __builtin_amdgcn_s_waitcnt(0);
        unsigned nloc = b.st[0], nx = b.st[1];
        if (nloc == 0u) { xcd_barrier_complete(bar, b.x, nloc, nx); b.st[0] = nloc; b.st[1] = nx; }
        const unsigned old = xb_add(&bar[XB_XSUB(b.x)], 1u);
        const unsigned gen = old / nloc;
        if (old + 1u == (gen + 1u) * nloc) {
            __builtin_amdgcn_fence(__ATOMIC_RELEASE, "agent");
            asm volatile("s_waitcnt vmcnt(0)" ::: "memory");
            const unsigned og = xb_add(&bar[XB_TOP], 1u);
            const unsigned tg = og / nx;
            if (og + 1u == (tg + 1u) * nx) xb_add(&bar[XB_TOPGEN], 1u);
            else XB_SPIN(xb_ld(&bar[XB_TOPGEN]) == tg, bar);
            __builtin_amdgcn_fence(__ATOMIC_ACQUIRE, "agent");
            xb_add(&bar[XB_XGEN(b.x)], 1u);
            asm volatile("s_waitcnt vmcnt(0)" ::: "memory");
        } else {
            XB_SPIN(xb_ld(&bar[XB_XGEN(b.x)]) == gen, bar);
            __builtin_amdgcn_fence(__ATOMIC_ACQUIRE, "agent");
            asm volatile("s_waitcnt vmcnt(0)" ::: "memory");
        }
    }
    __syncthreads();
}

constexpr int T = 16384, D = 1024, SEQ = 4096, NB = 4, INW = 5376, NL = 4;
constexpr int C_Q = 0, C_K = 1024, C_V = 1152, C_LX = 1280, C_LG = 2304, C_GA = 3328, C_GB = 4352;
constexpr int NE = 16, FF = 512;
constexpr float ALPHA = 1.681792830507429f;
constexpr float LN_EPS = 1e-5f;
constexpr float LOG2E = 1.4426950408889634f;
constexpr size_t MiB = 1u << 20;
constexpr size_t WS_CTL = 0, CTL_ZERO_BYTES = 1 * MiB;
constexpr int CW_TMO = 0, CW_BAR = 4096, CW_CNT = 16384;
constexpr size_t WS_MOD = 1 * MiB;
constexpr size_t WS_SUM = 2 * MiB;
constexpr size_t WS_EIDX = 3 * MiB;
constexpr size_t WS_EW = 3 * MiB + 512 * 1024;
constexpr size_t WS_LIST = 4 * MiB;
constexpr size_t WS_LRUW = 5 * MiB;
constexpr size_t WS_WIN = 6 * MiB;
constexpr size_t WS_WO = 17 * MiB;
constexpr size_t WS_WGU = 19 * MiB;
constexpr size_t WS_WD = 51 * MiB;
constexpr size_t WS_U = 68 * MiB;
constexpr size_t WS_P = 100 * MiB;
constexpr size_t WS_Y = 268 * MiB;
constexpr size_t WS_H = 300 * MiB;
constexpr size_t WS_END = 336 * MiB;
constexpr size_t WS_TA = 336 * MiB, WS_TI = 400 * MiB, WS_TZ = 464 * MiB, WS_END_HYB = 528 * MiB;

constexpr int NWAVES = 8;
constexpr int RING_OFF = 0, RING_BYTES = 131072;
constexpr int LDSCTL_OFF = RING_BYTES;
constexpr int LDS_BYTES = 147456;

typedef float f32x16 __attribute__((ext_vector_type(16)));
typedef unsigned u32x2 __attribute__((ext_vector_type(2)));
__device__ __forceinline__ float bf2f(unsigned v) { return __uint_as_float(v << 16); }
__device__ __forceinline__ float fast_sigmoid(float x) { return __builtin_amdgcn_rcpf(1.0f + __builtin_amdgcn_exp2f(-LOG2E * x)); }
__device__ __forceinline__ float gelu_tanh_f(float x) { const float u = 0.7978845608028654f * (x + 0.044715f * x * x * x); return x * fast_sigmoid(2.0f * u); }
template <int CTRL, int ROW_MASK>
__device__ __forceinline__ float dpp_add(float v) {
    return v + __int_as_float(__builtin_amdgcn_update_dpp(0, __float_as_int(v), CTRL, ROW_MASK, 0xF, false)); }
__device__ __forceinline__ float wave_sum(float v) {
    v = dpp_add<0xB1, 0xF>(v);
    v = dpp_add<0x4E, 0xF>(v);
    v = dpp_add<0x141, 0xF>(v);
    v = dpp_add<0x140, 0xF>(v);
    v = dpp_add<0x142, 0xA>(v);
    v = dpp_add<0x143, 0xC>(v);
    return __int_as_float(__builtin_amdgcn_readlane(__float_as_int(v), 63));
}
__constant__ int c_bucket[128] = {0, 1, 2, 3, 4, 5, 6, 7, 8, 9, 10, 11, 12, 13, 14, 15, 16, 16, 16, 17, 17, 18, 18, 18, 19, 19, 19, 20, 20, 20, 20, 21, 21, 21, 21, 22, 22, 22, 22, 22, 23, 23, 23, 23, 23, 23, 24, 24, 24, 24, 24, 24, 25, 25, 25, 25, 25, 25, 25, 26, 26, 26, 26, 26, 26, 26, 26, 27, 27, 27, 27, 27, 27, 27, 27, 27, 27, 28, 28, 28, 28, 28, 28, 28, 28, 28, 28, 29, 29, 29, 29, 29, 29, 29, 29, 29, 29, 29, 29, 30, 30, 30, 30, 30, 30, 30, 30, 30, 30, 30, 30, 30, 30, 31, 31, 31, 31, 31, 31, 31, 31, 31, 31, 31, 31, 31, 31, 31};

struct Ptrs {
    const float *x, *c, *ada_w, *ada_b, *w_in, *attn_sink, *rel_bias, *conv_w, *conv_b, *lru_wa, *lru_ba, *lru_wx, *lru_bx, *lru_lambda, *w_out, *ln1_g, *ln1_b, *router_w, *router_b, *moe_wg, *moe_wu, *moe_wd, *ln2_g, *ln2_b;
    float* out; unsigned char* ws;
};

__device__ __forceinline__ void transpose_item(const float* W, int K, int N, bf16* WT, int row_off, int item, int lane) {
    const int nblk = N / 32, kbi = item / nblk, nb = item % nblk, k0 = 64 * kbi + 8 * (lane >> 3), n0 = 32 * nb + 4 * (lane & 7);
    f32x4 v[8];
#pragma unroll
    for (int i = 0; i < 8; ++i) v[i] = *(const f32x4*)(W + (size_t)(k0 + i) * N + n0);
#pragma unroll
    for (int j = 0; j < 4; ++j) { v4u o; o.x = pk2(v[0][j], v[1][j]); o.y = pk2(v[2][j], v[3][j]); o.z = pk2(v[4][j], v[5][j]); o.w = pk2(v[6][j], v[7][j]);
        *(GAS v4u*)(WT + (size_t)(row_off + n0 + j) * K + k0) = o; }
}
__device__ __forceinline__ void convert_layer(const Ptrs& p, int l, LAS unsigned char* lds, int gw, int NGW, int wave, int lane) {
    (void)lds; (void)wave;
    constexpr int I_IN = (D / 64) * (INW / 32), I_O = (D / 64) * (D / 32), I_GU = 2 * NE * 256, I_D = NE * 256, I_L = 128;
    constexpr int NITEMS = I_IN + I_O + I_GU + I_D + I_L;
    bf16* WinT = (bf16*)(p.ws + WS_WIN); bf16* WoT = (bf16*)(p.ws + WS_WO); bf16* WguT = (bf16*)(p.ws + WS_WGU); bf16* WdT = (bf16*)(p.ws + WS_WD); bf16* waT = (bf16*)(p.ws + WS_LRUW); bf16* wxT = waT + 8 * 128 * 128;
    for (int it = gw; it < NITEMS; it += NGW) {
        int r = it;
        if (r < I_IN) { transpose_item(p.w_in + (size_t)l * D * INW, D, INW, WinT, 0, r, lane); continue; } r -= I_IN;
        if (r < I_O) { transpose_item(p.w_out + (size_t)l * D * D, D, D, WoT, 0, r, lane); continue; } r -= I_O;
        if (r < I_GU) { const int mat = r / (NE * 256); const int q = r % (NE * 256); const int e = q / 256, ti = q % 256; const int n0 = 32 * (ti % 16);
            const float* W = (mat ? p.moe_wu : p.moe_wg) + ((size_t)l * NE + e) * D * FF;
            transpose_item(W, D, FF, WguT, e * 1024 + (n0 / 128) * 256 + mat * 128 + (n0 % 128) - n0, ti, lane); continue; } r -= I_GU;
        if (r < I_D) { const int e = r / 256, ti = r % 256; transpose_item(p.moe_wd + ((size_t)l * NE + e) * FF * D, FF, D, WdT, e * 1024, ti, lane); continue; } r -= I_D;
        { const int mat = r / 64; const int q = r % 64; const int hb = q / 8, ti = q % 8;
            transpose_item((mat ? p.lru_wx : p.lru_wa) + ((size_t)l * 8 + hb) * 128 * 128, 128, 128, mat ? wxT : waT, hb * 128, ti, lane); }
    }
}
__device__ __forceinline__ void mod_item(const Ptrs& p, int item, LAS unsigned char* lds, int tid, int wave, int lane) {
    LAS float* ca = (LAS float*)lds;
    LAS float* red = (LAS float*)(lds + 16384);
    const int l = item / 24, j0 = (item % 24) * 256;
    for (int i = tid; i < NB * D; i += 512) { const float v = p.c[i]; ca[i] = v * fast_sigmoid(v); }
    __syncthreads();
    f32x4 acc[NB];
#pragma unroll
    for (int b = 0; b < NB; ++b) acc[b] = (f32x4){0.f, 0.f, 0.f, 0.f};
    const float* w = p.ada_w + (size_t)l * D * 6144 + j0 + 4 * lane;
#pragma unroll 8
    for (int kk = 0; kk < 128; ++kk) { const int k = wave * 128 + kk; const f32x4 wv = *(const f32x4*)(w + (size_t)k * 6144);
#pragma unroll
        for (int b = 0; b < NB; ++b) acc[b] += wv * ca[b * D + k]; }
#pragma unroll
    for (int b = 0; b < NB; ++b) *(LAS f32x4*)(red + (wave * NB + b) * 256 + 4 * lane) = acc[b];
    __syncthreads();
    float* mod = (float*)(p.ws + WS_MOD);
    for (int i = tid; i < NB * 256; i += 512) { const int b = i / 256, jj = i % 256; float s = 0.f;
#pragma unroll
        for (int w8 = 0; w8 < 8; ++w8) s += red[(w8 * NB + b) * 256 + jj];
        mod[((size_t)l * NB + b) * 6144 + j0 + jj] = s + p.ada_b[l * 6144 + j0 + jj]; }
    __syncthreads();
}
__device__ __forceinline__ void modulate_rows(const float* x, const float* mod_l, bf16* U, int gw, int NGW, int lane) {
    for (int row = gw; row < T; row += NGW) { const float* m = mod_l + (size_t)(row / SEQ) * 6144;
#pragma unroll
        for (int j = 0; j < 4; ++j) { const int col = 4 * lane + 256 * j; const f32x4 xv = *(const f32x4*)(x + (size_t)row * D + col), sh = *(const f32x4*)(m + col), sc = *(const f32x4*)(m + 1024 + col);
            const f32x4 u = xv * (sc + 1.0f) + sh; u32x2 o; o.x = pk2(u[0], u[1]); o.y = pk2(u[2], u[3]); *(u32x2*)(U + (size_t)row * D + col) = o; } }
}

constexpr int KS_STRIDE = 144;
constexpr int VT_STRIDE = 520;
constexpr int XC_STRIDE = 272;
constexpr int LB_K = 0, LB_V = 256 * KS_STRIDE  , LB_TBL = LB_V + 64 * VT_STRIDE  , LB_XC = LB_TBL + 8 * 192 * 4  , LB_END = LB_XC + 4 * 32 * XC_STRIDE  ;
constexpr int LB_CARRY = LB_END;
static_assert(LB_CARRY + 2048 <= RING_BYTES, "phase B LDS");

template <bool FINAL>
__device__ __forceinline__ void phase_b(const Ptrs& p, int l, LAS unsigned char* lds, int vcu, int G) {
    const bf16* P = (const bf16*)(p.ws + WS_P); bf16* Y = (bf16*)(p.ws + WS_Y);
    float* SA = (float*)(p.ws + WS_SUM); float* SB = SA + NB * 32 * 1024;
    const bf16* waT = (const bf16*)(p.ws + WS_LRUW); const bf16* wxT = waT + 8 * 128 * 128;
    for (int unit = vcu; unit < 256; unit += G) {
        int tid = threadIdx.x; asm volatile("" : "+v"(tid));
        const int lane = tid & 63, w = __builtin_amdgcn_readfirstlane(tid >> 6), l31 = lane & 31, hi = lane >> 5;
        const int b = unit >> 6, n = (unit & 63) >> 1, half = unit & 1;
        const int row0 = b * SEQ + n * 128;
        __syncthreads();
        if (FINAL) {
#pragma unroll
            for (int it = 0; it < 4; ++it) { const int idx = it * 512 + tid, r = idx >> 3, ch = idx & 7;
                v4u v = (v4u){0u, 0u, 0u, 0u};
                if (n > 0 || r >= 128) v = *(const v4u*)(P + (size_t)(row0 - 128 + r) * INW + C_K + half * 64 + ch * 8);
                *(LAS v4u*)(lds + LB_K + r * KS_STRIDE + ch * 16) = v; }
            { const int kg = tid >> 3, dc = tid & 7; v4u v[4];
#pragma unroll
                for (int i = 0; i < 4; ++i) { const int r = 4 * kg + i; v[i] = (v4u){0u, 0u, 0u, 0u};
                    if (n > 0 || r >= 128) v[i] = *(const v4u*)(P + (size_t)(row0 - 128 + r) * INW + C_V + half * 64 + dc * 8); }
#pragma unroll
                for (int d2 = 0; d2 < 4; ++d2) {
                    const unsigned a0 = v[0][d2], a1 = v[1][d2], a2 = v[2][d2], a3 = v[3][d2];
                    u32x2 lo, hh; lo.x = (a0 & 0xffffu) | (a1 << 16); lo.y = (a2 & 0xffffu) | (a3 << 16); hh.x = (a0 >> 16) | (a1 & 0xffff0000u); hh.y = (a2 >> 16) | (a3 & 0xffff0000u);
                    *(LAS u32x2*)(lds + LB_V + (dc * 8 + 2 * d2) * VT_STRIDE + kg * 8) = lo; *(LAS u32x2*)(lds + LB_V + (dc * 8 + 2 * d2 + 1) * VT_STRIDE + kg * 8) = hh; } }
#pragma unroll
            for (int i = 0; i < 3; ++i) { const int idx = tid + 512 * i, hd = idx / 192, xi = idx % 192, xx = xi - 32;
                float v = -INFINITY; if (xx >= 0 && xx < 128) v = p.rel_bias[c_bucket[127 - xx] * 16 + half * 8 + hd] * LOG2E;
                ((LAS float*)(lds + LB_TBL))[idx] = v; }
        }
        const int hbl = w >> 1, jb = (w & 1) * 64;
        const int hb = half * 4 + hbl;
        float hprev[2], atot[2];
#pragma unroll
        for (int dh = 0; dh < 2; ++dh) { const int ch = hb * 128 + jb + dh * 32 + l31;
            hprev[dh] = 0.f; atot[dh] = 1.f; (void)ch; }
        if (FINAL) {
            const size_t o0 = (size_t)b * 32 * 1024 + half * 512 + tid; float h = 0.f; int q = 0;
            for (; q + 8 <= n; q += 8) { float a8[8], b8[8];
#pragma unroll
                for (int u = 0; u < 8; ++u) { a8[u] = SA[o0 + (size_t)(q + u) * 1024]; b8[u] = SB[o0 + (size_t)(q + u) * 1024]; }
#pragma unroll
                for (int u = 0; u < 8; ++u) h = a8[u] * h + b8[u]; }
            for (; q < n; ++q) h = SA[o0 + (size_t)q * 1024] * h + SB[o0 + (size_t)q * 1024];
            ((LAS float*)(lds + LB_CARRY))[tid] = h; }
        const float sink2 = FINAL ? p.attn_sink[l * 16 + half * 8 + w] * LOG2E : 0.f;
#pragma unroll 1
        for (int c = 0; c < 4; ++c) {
            __syncthreads();
            { const int tg = tid >> 6, cg = tid & 63, chc = half * 512 + 8 * cg;
                const int t0 = row0 + 32 * c + 4 * tg;
                v4u xr[7];
#pragma unroll
                for (int i = 0; i < 7; ++i) { xr[i] = (v4u){0u, 0u, 0u, 0u}; if (n > 0 || c > 0 || tg > 0 || i >= 3) xr[i] = *(const v4u*)(P + (size_t)(t0 - 3 + i) * INW + C_LX + chc); }
                f32x4 cwv[5][2];
#pragma unroll
                for (int q = 0; q < 4; ++q) { cwv[q][0] = *(const f32x4*)(p.conv_w + ((size_t)l * 4 + q) * D + chc); cwv[q][1] = *(const f32x4*)(p.conv_w + ((size_t)l * 4 + q) * D + chc + 4); }
                cwv[4][0] = *(const f32x4*)(p.conv_b + l * D + chc); cwv[4][1] = *(const f32x4*)(p.conv_b + l * D + chc + 4);
#pragma unroll
                for (int k = 0; k < 4; ++k) { v4u o;
#pragma unroll
                    for (int d2 = 0; d2 < 4; ++d2) { float r2[2];
#pragma unroll
                        for (int e = 0; e < 2; ++e) { const int cc = 2 * d2 + e; float acc = cwv[4][cc >> 2][cc & 3];
#pragma unroll
                            for (int q = 0; q < 4; ++q) { const unsigned wd = xr[k + q][d2]; acc += cwv[q][cc >> 2][cc & 3] * (e ? bf2f(wd >> 16) : bf2f(wd & 0xffffu)); }
                            r2[e] = acc; }
                        o[d2] = pk2(r2[0], r2[1]); }
                    *(LAS v4u*)(lds + LB_XC + (cg >> 4) * (32 * XC_STRIDE) + (4 * tg + k) * XC_STRIDE + (cg & 15) * 16) = o; } }
            __syncthreads();
            f32x16 O[2];
            if (FINAL && c == 0) { hprev[0] = ((const LAS float*)(lds + LB_CARRY))[w * 64 + l31]; hprev[1] = ((const LAS float*)(lds + LB_CARRY))[w * 64 + 32 + l31]; }
            if (FINAL) {
                const int hq = half * 8 + w;
                bf16x8 qr[4];
#pragma unroll
                for (int ks = 0; ks < 4; ++ks) qr[ks] = *(const bf16x8*)(P + (size_t)(row0 + 32 * c + l31) * INW + C_Q + hq * 64 + 16 * ks + 8 * hi);
                f32x16 st[5];
#pragma unroll
                for (int jj = 0; jj < 5; ++jj) { st[jj] = (f32x16){};
#pragma unroll
                    for (int ks = 0; ks < 4; ++ks) { const bf16x8 kf = *(const LAS bf16x8*)(lds + LB_K + (32 * (c + jj) + l31) * KS_STRIDE + (16 * ks + 8 * hi) * 2);
                        st[jj] = __builtin_amdgcn_mfma_f32_32x32x16_bf16(kf, qr[ks], st[jj], 0, 0, 0); } }
                const LAS float* tb = (const LAS float*)(lds + LB_TBL) + w * 192 + (31 - l31 + 4 * hi);
                float m = sink2;
#pragma unroll
                for (int jj = 0; jj < 5; ++jj) { const bool dead = (n == 0) && (c + jj < 4);
#pragma unroll
                    for (int r = 0; r < 16; ++r) { float v = st[jj][r] * (0.125f * LOG2E) + tb[32 * jj + (r & 3) + 8 * (r >> 2)]; if (dead) v = -INFINITY; st[jj][r] = v; m = fmaxf(m, v); } }
                m = fmaxf(m, __shfl_xor(m, 32));
                float sum = 0.f;
#pragma unroll
                for (int jj = 0; jj < 5; ++jj)
#pragma unroll
                    for (int r = 0; r < 16; ++r) { const float e = __builtin_amdgcn_exp2f(st[jj][r] - m); st[jj][r] = e; sum += e; }
                sum += __shfl_xor(sum, 32);
                const float inv = __builtin_amdgcn_rcpf(sum + __builtin_amdgcn_exp2f(sink2 - m));
                O[0] = (f32x16){}; O[1] = (f32x16){};
#pragma unroll
                for (int jj = 0; jj < 5; ++jj)
#pragma unroll
                    for (int s2 = 0; s2 < 2; ++s2) {
                        v4u pw; pw.x = pk2(st[jj][8 * s2 + 0] * inv, st[jj][8 * s2 + 1] * inv); pw.y = pk2(st[jj][8 * s2 + 2] * inv, st[jj][8 * s2 + 3] * inv);
                        pw.z = pk2(st[jj][8 * s2 + 4] * inv, st[jj][8 * s2 + 5] * inv); pw.w = pk2(st[jj][8 * s2 + 6] * inv, st[jj][8 * s2 + 7] * inv);
                        const bf16x8 pa = __builtin_bit_cast(bf16x8, pw);
                        const int key0 = 32 * (c + jj) + 16 * s2 + 4 * hi;
#pragma unroll
                        for (int dh = 0; dh < 2; ++dh) { const LAS unsigned char* vp = lds + LB_V + (dh * 32 + l31) * VT_STRIDE + key0 * 2;
                            const u32x2 lo = *(const LAS u32x2*)vp, h2 = *(const LAS u32x2*)(vp + 16);
                            v4u vw; vw.x = lo.x; vw.y = lo.y; vw.z = h2.x; vw.w = h2.y;
                            O[dh] = __builtin_amdgcn_mfma_f32_32x32x16_bf16(pa, __builtin_bit_cast(bf16x8, vw), O[dh], 0, 0, 0); } }
            }
#pragma unroll
            for (int dh = 0; dh < 2; ++dh) {
                const int jcol = jb + dh * 32 + l31;
                const float ba_v = p.lru_ba[l * D + hb * 128 + jcol], bx_v = p.lru_bx[l * D + hb * 128 + jcol];
                const float kk_v = -8.0f * log1pf(__expf(-p.lru_lambda[l * D + hb * 128 + jcol]));
                f32x16 ra = (f32x16){}, ia = (f32x16){};
                const bf16* wap = waT + ((size_t)hb * 128 + jcol) * 128 + 8 * hi; const bf16* wxp = wxT + ((size_t)hb * 128 + jcol) * 128 + 8 * hi;
#pragma unroll
                for (int ks = 0; ks < 8; ++ks) { const bf16x8 af = *(const LAS bf16x8*)(lds + LB_XC + hbl * (32 * XC_STRIDE) + l31 * XC_STRIDE + (16 * ks + 8 * hi) * 2);
                    const bf16x8 bwa = *(const bf16x8*)(wap + 16 * ks), bwx = *(const bf16x8*)(wxp + 16 * ks);
                    ra = __builtin_amdgcn_mfma_f32_32x32x16_bf16(af, bwa, ra, 0, 0, 0); ia = __builtin_amdgcn_mfma_f32_32x32x16_bf16(af, bwx, ia, 0, 0, 0); }
                float av[16], bv[16];
                const LAS unsigned short* xcol = (const LAS unsigned short*)(lds + LB_XC + hbl * (32 * XC_STRIDE)) + jcol;
#pragma unroll
                for (int r = 0; r < 16; ++r) { const int tok = (r & 3) + 8 * (r >> 2) + 4 * hi;
                    const float rr = fast_sigmoid(ra[r] + ba_v), ii = fast_sigmoid(ia[r] + bx_v);
                    const float la = kk_v * rr;
                    const float a = __builtin_amdgcn_exp2f(la * LOG2E);
                    const float e2 = 2.0f * la;
                    const float om = (e2 > -0.1f) ? -e2 * (1.0f + e2 * (0.5f + e2 * (0.16666667f + e2 * 0.041666668f))) : 1.0f - a * a;
                    const float xc = bf2f(xcol[tok * (XC_STRIDE / 2)]);
                    av[r] = a; bv[r] = __builtin_sqrtf(om) * (ii * xc); }
                float Ag[4], Bg[4], Ap[4], Bp[4];
#pragma unroll
                for (int g = 0; g < 4; ++g) { float A = av[4 * g], B = bv[4 * g];
#pragma unroll
                    for (int e = 1; e < 4; ++e) { B = av[4 * g + e] * B + bv[4 * g + e]; A *= av[4 * g + e]; }
                    Ag[g] = A; Bg[g] = B; Ap[g] = __shfl_xor(A, 32); Bp[g] = __shfl_xor(B, 32); }
                float hs = hprev[dh], At = atot[dh], stt[4];
#pragma unroll
                for (int g = 0; g < 4; ++g) { const float A0 = hi ? Ap[g] : Ag[g], B0 = hi ? Bp[g] : Bg[g], A1 = hi ? Ag[g] : Ap[g], B1 = hi ? Bg[g] : Bp[g];
                    const float s0 = hs; hs = A0 * hs + B0; const float s1 = hs; hs = A1 * hs + B1; stt[g] = hi ? s1 : s0; At *= A0 * A1; }
                hprev[dh] = hs; atot[dh] = At;
                if (FINAL) {
                    const int col = hb * 128 + jcol;
#pragma unroll
                    for (int g = 0; g < 4; ++g) { float h = stt[g];
#pragma unroll
                        for (int e = 0; e < 4; ++e) { const int r = 4 * g + e; h = av[r] * h + bv[r];
                            const size_t trow = (size_t)(row0 + 32 * c + (r & 3) + 8 * (r >> 2) + 4 * hi);
                            const bf16* pr = P + trow * INW + col;
                            const float ga = bf2f(pr[C_GA]), gb = bf2f(pr[C_GB]), lg = bf2f(pr[C_LG]);
                            const float y = fast_sigmoid(ga) * O[dh][r] + fast_sigmoid(gb) * gelu_tanh_f(lg) * h;
                            Y[trow * D + col] = (bf16)f2bf(y); } }
                }
            }
        }
        if (!FINAL) {
#pragma unroll
            for (int dh = 0; dh < 2; ++dh) if (hi == 0) { const size_t o = ((size_t)b * 32 + n) * 1024 + hb * 128 + jb + dh * 32 + l31; SA[o] = atot[dh]; SB[o] = hprev[dh]; }
        }
    }
}

template <bool DRY>
__device__ __forceinline__ void phase_ln1(const Ptrs& p, int l, LAS unsigned char* lds, int gw, int NGW, int tid, int lane) {
    LAS float* rwT = (LAS float*)lds;
    for (int i = tid; i < D * NE; i += 512) rwT[(i & 15) * D + (i >> 4)] = p.router_w[i];
    __syncthreads();
    const float* xin = (l == 0) ? p.x : p.out; float* xout = DRY ? (float*)(p.ws + WS_TA) : p.out;
    const bf16* Z = (const bf16*)(p.ws + WS_H); bf16* U = DRY ? (bf16*)(p.ws + WS_TI) : (bf16*)(p.ws + WS_U);
    const float* mod_l = (const float*)(p.ws + WS_MOD) + (size_t)l * NB * 6144;
    int* eidx = (int*)(p.ws + (DRY ? WS_TZ : WS_EIDX)); float* ew = (float*)(p.ws + (DRY ? WS_TZ + MiB : WS_EW)); int* list = (int*)(p.ws + (DRY ? WS_TZ + 2 * MiB : WS_LIST));
    unsigned* cnt = (unsigned*)(p.ws + WS_CTL) + CW_CNT + l * 1024 + (DRY ? 8192 : 0);
    const float* g = p.ln1_g + l * D; const float* bt = p.ln1_b + l * D;
    LAS int* lcnt = (LAS int*)(lds + 65536); LAS int* lbase = lcnt + 16; LAS int* wrec = lcnt + 32 + (tid >> 6) * 32;
    const int nIt = (T + NGW - 1) / NGW;
    for (int it0 = 0; it0 < nIt; it0 += 8) {
    if (tid < 16) lcnt[tid] = 0;
    __syncthreads();
    f32x4 xq[4]; u32x2 zq[4];
    { const int row = gw + it0 * NGW; if (row < T) {
#pragma unroll
        for (int j = 0; j < 4; ++j) { const int col = 4 * lane + 256 * j; xq[j] = *(const f32x4*)(xin + (size_t)row * D + col); zq[j] = *(const u32x2*)(Z + (size_t)row * D + col); } } }
#pragma unroll 1
    for (int kk = 0; kk < 8; ++kk) { const int row = gw + (it0 + kk) * NGW; if (row >= T) break;
        const float* m = mod_l + (size_t)(row / SEQ) * 6144;
        f32x4 xc_[4]; u32x2 zc_[4];
#pragma unroll
        for (int j = 0; j < 4; ++j) { xc_[j] = xq[j]; zc_[j] = zq[j]; }
        { const int rown = row + NGW; if (kk + 1 < 8 && rown < T) {
#pragma unroll
            for (int j = 0; j < 4; ++j) { const int col = 4 * lane + 256 * j; xq[j] = *(const f32x4*)(xin + (size_t)rown * D + col); zq[j] = *(const u32x2*)(Z + (size_t)rown * D + col); } } }
        f32x4 v[4]; float s = 0.f;
#pragma unroll
        for (int j = 0; j < 4; ++j) { const int col = 4 * lane + 256 * j; const f32x4 xv = xc_[j], g1 = *(const f32x4*)(m + 2048 + col);
            const u32x2 zz = zc_[j];
            const f32x4 zf = (f32x4){bf2f(zz.x & 0xffffu), bf2f(zz.x >> 16), bf2f(zz.y & 0xffffu), bf2f(zz.y >> 16)};
            v[j] = xv * ALPHA + g1 * zf; s += (v[j][0] + v[j][1]) + (v[j][2] + v[j][3]); }
        const float mean = wave_sum(s) * (1.f / D); float q = 0.f;
#pragma unroll
        for (int j = 0; j < 4; ++j) { v[j] = v[j] - mean; q += (v[j][0] * v[j][0] + v[j][1] * v[j][1]) + (v[j][2] * v[j][2] + v[j][3] * v[j][3]); }
        const float rstd = 1.0f / sqrtf(wave_sum(q) * (1.f / D) + LN_EPS);
        float lg[16];
#pragma unroll
        for (int e = 0; e < 16; ++e) lg[e] = 0.f;
#pragma unroll
        for (int j = 0; j < 4; ++j) { const int col = 4 * lane + 256 * j; const f32x4 gm = *(const f32x4*)(g + col), be = *(const f32x4*)(bt + col);
            const f32x4 xn = v[j] * rstd * gm + be; *(f32x4*)(xout + (size_t)row * D + col) = xn;
            const f32x4 sc = *(const f32x4*)(m + 4096 + col), sh = *(const f32x4*)(m + 3072 + col); const f32x4 uu = xn * (sc + 1.0f) + sh;
            u32x2 o; o.x = pk2(uu[0], uu[1]); o.y = pk2(uu[2], uu[3]); *(u32x2*)(U + (size_t)row * D + col) = o;
#pragma unroll
            for (int e = 0; e < 16; ++e) { const f32x4 rw = *(const LAS f32x4*)(rwT + e * D + col); lg[e] += (uu[0] * rw[0] + uu[1] * rw[1]) + (uu[2] * rw[2] + uu[3] * rw[3]); }
            asm volatile("" ::: "memory"); }
#pragma unroll
        for (int e = 0; e < 16; ++e) lg[e] = wave_sum(lg[e]);
        float sc[16]; float mx = -INFINITY;
#pragma unroll
        for (int e = 0; e < 16; ++e) { sc[e] = lg[e] + p.router_b[e]; mx = fmaxf(mx, sc[e]); }
        float sum = 0.f;
#pragma unroll
        for (int e = 0; e < 16; ++e) { sc[e] = __expf(sc[e] - mx); sum += sc[e]; }
        const float isum = 1.0f / sum;
#pragma unroll
        for (int e = 0; e < 16; ++e) sc[e] *= isum;
        int gsel = 0, bi0 = 0, bi1 = 1; float best = -1.f, bw0 = 0.f, bw1 = 0.f;
#pragma unroll
        for (int gI = 0; gI < 4; ++gI) {
            int i0 = 0; float w0 = sc[gI * 4];
#pragma unroll
            for (int k = 1; k < 4; ++k) if (sc[gI * 4 + k] > w0) { w0 = sc[gI * 4 + k]; i0 = k; }
            int i1 = -1; float w1 = -1.f;
#pragma unroll
            for (int k = 0; k < 4; ++k) if (k != i0 && sc[gI * 4 + k] > w1) { w1 = sc[gI * 4 + k]; i1 = k; }
            const float gs = w0 + w1;
            if (gs > best) { best = gs; gsel = gI; bi0 = i0; bi1 = i1; bw0 = w0; bw1 = w1; }
        }
        if (lane == 0) {
            const float wsum = bw0 + bw1; const int e0 = gsel * 4 + bi0, e1 = gsel * 4 + bi1;
            eidx[row * 2 + 0] = e0; eidx[row * 2 + 1] = e1; ew[row * 2 + 0] = bw0 / wsum; ew[row * 2 + 1] = bw1 / wsum;
            wrec[kk * 4 + 0] = e0; wrec[kk * 4 + 1] = __hip_atomic_fetch_add(lcnt + e0, 1, __ATOMIC_RELAXED, __HIP_MEMORY_SCOPE_WORKGROUP);
            wrec[kk * 4 + 2] = e1; wrec[kk * 4 + 3] = __hip_atomic_fetch_add(lcnt + e1, 1, __ATOMIC_RELAXED, __HIP_MEMORY_SCOPE_WORKGROUP);
        }
    }
    __syncthreads();
    if (tid < 16) lbase[tid] = (int)__hip_atomic_fetch_add(cnt + 64 * tid, (unsigned)lcnt[tid], __ATOMIC_RELAXED, __HIP_MEMORY_SCOPE_AGENT);
    __syncthreads();
    if (lane < 8) { const int row = gw + (it0 + lane) * NGW;
        if (row < T) { const int e0 = wrec[lane * 4 + 0], r0 = wrec[lane * 4 + 1], e1 = wrec[lane * 4 + 2], r1 = wrec[lane * 4 + 3];
            list[e0 * 16384 + lbase[e0] + r0] = row * 2 + 0; list[e1 * 16384 + lbase[e1] + r1] = row * 2 + 1; } }
    __syncthreads();
    }
}
template <bool DRY>
__device__ __forceinline__ void phase_ln2(const Ptrs& p, int l, int gw, int NGW, int lane) {
    float* x = p.out; float* xo = DRY ? (float*)(p.ws + WS_TA) : p.out; const bf16* F0 = (const bf16*)(p.ws + WS_P); const bf16* F1 = F0 + (size_t)T * D; bf16* U = (bf16*)(p.ws + WS_U);
    const float* mod_l = (const float*)(p.ws + WS_MOD) + (size_t)l * NB * 6144; const float* mod_n = mod_l + NB * 6144;
    const float* ew = (const float*)(p.ws + WS_EW); if (DRY) U = (bf16*)(p.ws + WS_TI);
    const float* g = p.ln2_g + l * D; const float* bt = p.ln2_b + l * D;
    f32x4 xq[4]; u32x2 aq[4], cq[4]; float wq = 0.f;
    if (gw < T) { wq = ew[gw * 2 + (lane & 1)];
#pragma unroll
        for (int j = 0; j < 4; ++j) { const int col = 4 * lane + 256 * j; xq[j] = *(const f32x4*)(x + (size_t)gw * D + col); aq[j] = *(const u32x2*)(F0 + (size_t)gw * D + col); cq[j] = *(const u32x2*)(F1 + (size_t)gw * D + col); } }
#pragma unroll 1
    for (int row = gw; row < T; row += NGW) {
        const float* m = mod_l + (size_t)(row / SEQ) * 6144; const float* mn = mod_n + (size_t)(row / SEQ) * 6144;
        const float wv = wq;
        f32x4 xc_[4]; u32x2 ac_[4], cc_[4];
#pragma unroll
        for (int j = 0; j < 4; ++j) { xc_[j] = xq[j]; ac_[j] = aq[j]; cc_[j] = cq[j]; }
        { const int rown = row + NGW; if (rown < T) { wq = ew[rown * 2 + (lane & 1)];
#pragma unroll
            for (int j = 0; j < 4; ++j) { const int col = 4 * lane + 256 * j; xq[j] = *(const f32x4*)(x + (size_t)rown * D + col); aq[j] = *(const u32x2*)(F0 + (size_t)rown * D + col); cq[j] = *(const u32x2*)(F1 + (size_t)rown * D + col); } } }
        const float w0 = __int_as_float(__builtin_amdgcn_readlane(__float_as_int(wv), 0)), w1 = __int_as_float(__builtin_amdgcn_readlane(__float_as_int(wv), 1));
        f32x4 v[4]; float s = 0.f;
#pragma unroll
        for (int j = 0; j < 4; ++j) { const int col = 4 * lane + 256 * j; const f32x4 xv = xc_[j], g2 = *(const f32x4*)(m + 5120 + col);
            const u32x2 a = ac_[j], c2 = cc_[j];
            const f32x4 f = (f32x4){bf2f(a.x & 0xffffu), bf2f(a.x >> 16), bf2f(a.y & 0xffffu), bf2f(a.y >> 16)} * w0 + (f32x4){bf2f(c2.x & 0xffffu), bf2f(c2.x >> 16), bf2f(c2.y & 0xffffu), bf2f(c2.y >> 16)} * w1;
            v[j] = xv * ALPHA + g2 * f; s += (v[j][0] + v[j][1]) + (v[j][2] + v[j][3]); }
        const float mean = wave_sum(s) * (1.f / D); float q = 0.f;
#pragma unroll
        for (int j = 0; j < 4; ++j) { v[j] = v[j] - mean; q += (v[j][0] * v[j][0] + v[j][1] * v[j][1]) + (v[j][2] * v[j][2] + v[j][3] * v[j][3]); }
        const float rstd = 1.0f / sqrtf(wave_sum(q) * (1.f / D) + LN_EPS);
#pragma unroll
        for (int j = 0; j < 4; ++j) { const int col = 4 * lane + 256 * j; const f32x4 gm = *(const f32x4*)(g + col), be = *(const f32x4*)(bt + col);
            const f32x4 xn = v[j] * rstd * gm + be; *(f32x4*)(xo + (size_t)row * D + col) = xn;
            if (l + 1 < NL) { const f32x4 sh = *(const f32x4*)(mn + col), sc = *(const f32x4*)(mn + 1024 + col); const f32x4 uu = xn * (sc + 1.0f) + sh;
                u32x2 o; o.x = pk2(uu[0], uu[1]); o.y = pk2(uu[2], uu[3]); *(u32x2*)(U + (size_t)row * D + col) = o; } }
    }
}
constexpr int N_PHASES = 2 + 8 * NL;
#ifndef REP_A
#define REP_A 1
#endif
#ifndef REP_B1
#define REP_B1 1
#endif
#ifndef REP_B2
#define REP_B2 1
#endif
#ifndef REP_C
#define REP_C 1
#endif
#ifndef REP_D
#define REP_D 1
#endif
#ifndef REP_E
#define REP_E 1
#endif
#ifndef REP_C2
#define REP_C2 1
#endif
#ifndef REP_F
#define REP_F 1
#endif
#ifndef REP_CV
#define REP_CV 1
#endif
#ifndef REP_P0
#define REP_P0 1
#endif
struct Args { const float* in[24]; float* out; unsigned char* ws; int ph_lo, ph_hi; };
__global__ void __launch_bounds__(NWAVES * 64, 2) fwd(Args args) {
    extern __shared__ __attribute__((aligned(16))) unsigned char lds_raw[];
    LAS unsigned char* lds = (LAS unsigned char*)lds_raw;
    const int tid = threadIdx.x, lane = tid & 63, wave = __builtin_amdgcn_readfirstlane(tid >> 6);
    const int G = gridDim.x, bx = blockIdx.x, vcu = (G % 8 == 0) ? (bx % 8) * (G / 8) + bx / 8 : bx;
    const int gw = vcu * NWAVES + wave, NGW = G * NWAVES;
    Ptrs p;
    p.x = args.in[0]; p.c = args.in[1]; p.ada_w = args.in[2]; p.ada_b = args.in[3]; p.w_in = args.in[4]; p.attn_sink = args.in[5]; p.rel_bias = args.in[6]; p.conv_w = args.in[7]; p.conv_b = args.in[8];
    p.lru_wa = args.in[9]; p.lru_ba = args.in[10]; p.lru_wx = args.in[11]; p.lru_bx = args.in[12]; p.lru_lambda = args.in[13]; p.w_out = args.in[14]; p.ln1_g = args.in[15]; p.ln1_b = args.in[16];
    p.router_w = args.in[17]; p.router_b = args.in[18]; p.moe_wg = args.in[19]; p.moe_wu = args.in[20]; p.moe_wd = args.in[21]; p.ln2_g = args.in[22]; p.ln2_b = args.in[23];
    p.out = args.out; p.ws = args.ws;
    LAS unsigned* ctlw = (LAS unsigned*)(lds + LDSCTL_OFF);
    for (int u = tid; u < 256; u += NWAVES * 64) ctlw[u] = 0u;
    __syncthreads();
    const int lo = args.ph_lo, hi = args.ph_hi;
    XcdBarrier bar; bar.bar = (unsigned*)(p.ws + WS_CTL) + CW_BAR; bar.x = 0; bar.st = nullptr;
    if (hi - lo > 1) bar = xcd_barrier_post((unsigned*)(p.ws + WS_CTL) + CW_BAR, (volatile LAS unsigned*)(ctlw + 16));
#define IN(k) (lo <= (k) && (k) < hi)
#define LAUNDER_TID() int tidp = threadIdx.x; asm volatile("" : "+v"(tidp)); const int lanep = tidp & 63, wavep = __builtin_amdgcn_readfirstlane(tidp >> 6), gwp = vcu * NWAVES + wavep; (void)lanep; (void)gwp
#define SEAM(k) do { if (IN(k) && IN((k) + 1)) xcd_barrier(bar); } while (0)
    bf16* U = (bf16*)(p.ws + WS_U); bf16* Pb = (bf16*)(p.ws + WS_P); bf16* Yb = (bf16*)(p.ws + WS_Y); bf16* Hb = (bf16*)(p.ws + WS_H);
    const float* mod = (const float*)(p.ws + WS_MOD);

    for (int rep_ = 0; rep_ < REP_P0; ++rep_) {
        if (IN(0)) { LAUNDER_TID(); if (bx < NL * 24) mod_item(p, bx, lds, tidp, wavep, lanep); convert_layer(p, 0, lds, gwp, NGW, wavep, lanep); }
    SEAM(0); }

    if (IN(1)) { LAUNDER_TID(); modulate_rows(p.x, mod, U, gwp, NGW, lanep); }
    SEAM(1);
#pragma unroll 1
    for (int l = 0; l < NL; ++l) {
        const int pb = 2 + 8 * l;
        for (int rep_ = 0; rep_ < REP_A; ++rep_) {
        if (IN(pb + 0)) { LAUNDER_TID(); pg8::Gemm g{U, (const bf16*)(p.ws + WS_WIN), T, INW, D}; pg8::StaticOrder S; S.init(T, INW, G, bx); pg8::EpiStoreBf16 E{Pb, INW};
            pg8::gemm_phase<pg8::EpiStoreBf16, pg8::StaticOrder, true, false>(lds + RING_OFF, g, S, E, tidp); }
        SEAM(pb + 0); }

        for (int rep_ = 0; rep_ < REP_B1; ++rep_) {
        if (IN(pb + 1)) phase_b<false>(p, l, lds, vcu, G);
        SEAM(pb + 1); }

        for (int rep_ = 0; rep_ < REP_B2; ++rep_) {
        if (IN(pb + 2)) phase_b<true>(p, l, lds, vcu, G);
        SEAM(pb + 2); }

        for (int rep_ = 0; rep_ < REP_C; ++rep_) {
        if (IN(pb + 3)) { LAUNDER_TID(); pg8::Gemm g{Yb, (const bf16*)(p.ws + WS_WO), T, D, D}; pg8::StaticOrder S; S.init(T, D, G, bx); pg8::EpiStoreBf16 E{Hb, D};
            pg8::gemm_phase<pg8::EpiStoreBf16, pg8::StaticOrder, false, false>(lds + RING_OFF, g, S, E, tidp); }
        SEAM(pb + 3); }

        for (int rep_ = 1; rep_ < REP_C2; ++rep_) { if (IN(pb + 4)) { LAUNDER_TID(); phase_ln1<true>(p, l, lds, gwp, NGW, tidp, lanep); } SEAM(pb + 3); }
        if (IN(pb + 4)) { LAUNDER_TID(); phase_ln1<false>(p, l, lds, gwp, NGW, tidp, lanep); }
        SEAM(pb + 4);
        for (int rep_ = 0; rep_ < REP_D; ++rep_) {
        if (IN(pb + 5)) { LAUNDER_TID();
            if (tidp < 16) ((LAS int*)ctlw)[tidp] = (int)__hip_atomic_load((unsigned*)(p.ws + WS_CTL) + CW_CNT + l * 1024 + 64 * tidp, __ATOMIC_RELAXED, __HIP_MEMORY_SCOPE_AGENT);
            __syncthreads();
            pg8::Gemm g{U, (const bf16*)(p.ws + WS_WGU), T, NE * 1024, D}; pg8::MoeOrder S{(const LAS int*)ctlw, (const int*)(p.ws + WS_LIST), G, vcu}; pg8::EpiMoeGU E{Hb};
            pg8::gemm_phase<pg8::EpiMoeGU, pg8::MoeOrder, true, true>(lds + RING_OFF, g, S, E, tidp); }
        SEAM(pb + 5); }

        for (int rep_ = 0; rep_ < REP_E; ++rep_) {
        if (IN(pb + 6)) { LAUNDER_TID();
            if (tidp < 16) ((LAS int*)ctlw)[tidp] = (int)__hip_atomic_load((unsigned*)(p.ws + WS_CTL) + CW_CNT + l * 1024 + 64 * tidp, __ATOMIC_RELAXED, __HIP_MEMORY_SCOPE_AGENT);
            __syncthreads();
            pg8::Gemm g{Hb, (const bf16*)(p.ws + WS_WD), 36864, NE * 1024, FF}; pg8::MoeOrder S{(const LAS int*)ctlw, (const int*)(p.ws + WS_LIST), G, vcu}; pg8::EpiMoeDown E{Pb, (const int*)(p.ws + WS_LIST), T};
            pg8::gemm_phase<pg8::EpiMoeDown, pg8::MoeOrder, true, false>(lds + RING_OFF, g, S, E, tidp); }
        SEAM(pb + 6); }

        for (int rep_ = 1; rep_ < REP_F; ++rep_) { if (IN(pb + 7)) { LAUNDER_TID(); phase_ln2<true>(p, l, gwp, NGW, lanep); } SEAM(pb + 6); }
        for (int rep_ = 1; rep_ < REP_CV; ++rep_) { if (IN(pb + 7)) { LAUNDER_TID(); if (l + 1 < NL) convert_layer(p, l + 1, lds, gwp, NGW, wavep, lanep); } SEAM(pb + 6); }
        if (IN(pb + 7)) { LAUNDER_TID(); phase_ln2<false>(p, l, gwp, NGW, lanep); if (l + 1 < NL) convert_layer(p, l + 1, lds, gwp, NGW, wavep, lanep); }
        SEAM(pb + 7);
    }
#undef IN
#undef SEAM
}
#ifndef MK_SPLIT
#define MK_SPLIT 0
#endif
extern "C" void kernel_launch(void* const* d_in, const int* in_sizes, int n_in, void* d_out, int out_size, void* d_ws, size_t ws_size, hipStream_t stream) {
    static int grid = 0;
    if (grid == 0) {
        if (n_in != 24 || in_sizes[0] != T * D || out_size != T * D || ws_size < WS_END) { fprintf(stderr, "kernel_launch: unexpected shapes (n_in %d, in0 %d, out %d, ws %zu); nothing launched\n", n_in, n_in > 0 ? in_sizes[0] : -1, out_size, ws_size); grid = -1; return; }
        int dev = 0, cus = 0, per_cu = 0;
        if (hipGetDevice(&dev) != hipSuccess || hipDeviceGetAttribute(&cus, hipDeviceAttributeMultiprocessorCount, dev) != hipSuccess) { fprintf(stderr, "kernel_launch: device query failed\n"); grid = -1; return; }
        if (hipFuncSetAttribute((const void*)fwd, hipFuncAttributeMaxDynamicSharedMemorySize, LDS_BYTES) != hipSuccess) { fprintf(stderr, "kernel_launch: hipFuncSetAttribute failed\n"); grid = -1; return; }
        if (hipOccupancyMaxActiveBlocksPerMultiprocessor(&per_cu, (const void*)fwd, NWAVES * 64, LDS_BYTES) != hipSuccess || per_cu < 1) fprintf(stderr, "kernel_launch: occupancy query reports %d blocks per CU\n", per_cu);
        (void)hipGetLastError();
        grid = cus;
    }
    if (grid < 0) return;
    if (hipMemsetAsync((char*)d_ws + WS_CTL, 0, CTL_ZERO_BYTES, stream) != hipSuccess) { fprintf(stderr, "kernel_launch: memset failed\n"); return; }
    Args a{};
    for (int i = 0; i < 24; ++i) a.in[i] = (const float*)d_in[i];
    a.out = (float*)d_out; a.ws = (unsigned char*)d_ws;
#if MK_SPLIT
    for (int ph = 0; ph < N_PHASES; ++ph) { a.ph_lo = ph; a.ph_hi = ph + 1; hipLaunchKernelGGL(fwd, dim3(grid), dim3(NWAVES * 64), LDS_BYTES, stream, a); }
#else
    a.ph_lo = 0; a.ph_hi = N_PHASES; hipLaunchKernelGGL(fwd, dim3(grid), dim3(NWAVES * 64), LDS_BYTES, stream, a);
#endif
    const hipError_t le = hipPeekAtLastError();
    if (le != hipSuccess) fprintf(stderr, "kernel_launch: launch failed: %s\n", hipGetErrorName(le));
}
```

```cpp
#include <hip/hip_runtime.h>
#include <cstdio>
#include <cstdint>
#define MK_SPLIT 0
namespace pg8 {
#define PG8_LAS __attribute__((address_space(3)))
typedef unsigned short bf16_t;
typedef short bf16x8 __attribute__((ext_vector_type(8)));
typedef float f32x4 __attribute__((ext_vector_type(4)));
typedef unsigned u32x4 __attribute__((ext_vector_type(4)));
constexpr int BM = 256, BK = 64, HALF = 128, HTB = HALF * BK * 2  , STAGE_BYTES = 8 * HTB, NXCD = 8, WGM = 8;

__host__ __device__ __forceinline__ int lds_byte(int r, int c) { const int st = (r >> 4) * 2 + (c >> 5), rr = r & 15, cc = c & 31, ob = rr * 64 + cc * 2; return st * 1024 + (ob ^ (((ob >> 9) & 1) << 5)); }
__host__ __device__ __forceinline__ void stage_rc(int b, int& R, int& C) { const int st = b / 1024, sb = b % 1024, swz = sb ^ (((sb >> 9) & 1) << 5); R = (st >> 1) * 16 + swz / 64; C = (st & 1) * 32 + (swz % 64) / 2; }
__host__ __device__ __forceinline__ int perm32(int rho) { const int n = rho >> 4, i = rho & 15; return 8 * (i >> 2) + 4 * n + (i & 3); }

struct Unit { int pm, pn, e, mt, nv; };
struct Gemm { const bf16_t* A; const bf16_t* Bt; int M, N, K; };

struct StaticOrder {
    int nM, nN, nwg, G, c;
    __host__ __device__ void init(int M, int N, int G_, int c_) { nM = M / BM; nN = N / BM; nwg = nM * nN; G = G_; c = c_; }
    __host__ __device__ bool next(int i, Unit& u) const {
        const long L = (long)i * G + c; if (L >= nwg) return false;
        int wgid = (int)L; { const int q = nwg / NXCD, r = nwg % NXCD, xcd = wgid % NXCD, off = wgid / NXCD; wgid = (xcd < r ? xcd * (q + 1) : r * (q + 1) + (xcd - r) * q) + off; }
        const int nig = WGM * nN, gid = wgid / nig, fm = gid * WGM, gsz = (nM - fm) < WGM ? (nM - fm) : WGM;
        u.pm = fm + ((wgid % nig) % gsz); u.pn = (wgid % nig) / gsz; u.e = 0; u.mt = 0; u.nv = 256; return true;
    }
    __device__ __forceinline__ void a_ready(const Unit&) const {}
    __device__ __forceinline__ void done(const Unit&) const {}
};

__device__ __forceinline__ unsigned cvt_pk_bf16(float lo, float hi) { unsigned r; asm volatile("v_cvt_pk_bf16_f32 %0, %1, %2" : "=v"(r) : "v"(lo), "v"(hi)); return r; }
typedef float f32x2 __attribute__((ext_vector_type(2)));
__device__ __forceinline__ f32x2 gelu_pk(f32x2 v) {
    const f32x2 av = __builtin_elementwise_abs(v), d = av * 0.2316418882f + 1.0f;
    f32x2 t; t.x = __builtin_amdgcn_rcpf(d.x); t.y = __builtin_amdgcn_rcpf(d.y);
    f32x2 q = t * 0.5307027145f + (-0.7265760135f); q = q * t + 0.7107068705f; q = q * t + (-0.142248368f); q = q * t + 0.127414796f; q = q * t;
    const f32x2 s = (v * v) * (-0.72134752044f);
    f32x2 e; e.x = __builtin_amdgcn_exp2f(s.x); e.y = __builtin_amdgcn_exp2f(s.y);
    const f32x2 m = v * (q * e), r = v - m;
    f32x2 o; o.x = v.x < 0.f ? m.x : r.x; o.y = v.y < 0.f ? m.y : r.y; return o;
}

struct EpiStoreBf16 {
    static constexpr bool PERM = true, AFTER_DRAIN = false;
    bf16_t* O; int ldc;
    __device__ __forceinline__ void operator()(const f32x4 (&acc)[2][2][4][2], const Unit& u, int wr, int wc, int fr, int fq) const {
        const int row0 = u.pm * BM + wr * 64 + fr, col0 = u.pn * BM + wc * 32 + 8 * fq;
#pragma unroll
        for (int ai = 0; ai < 2; ++ai)
#pragma unroll
            for (int m = 0; m < 4; ++m) { bf16_t* rowp = O + (size_t)(row0 + ai * HALF + m * 16) * ldc + col0;
#pragma unroll
                for (int bj = 0; bj < 2; ++bj) { const f32x4 v0 = acc[ai][bj][m][0], v1 = acc[ai][bj][m][1];
                    u32x4 w; w.x = cvt_pk_bf16(v0[0], v0[1]); w.y = cvt_pk_bf16(v0[2], v0[3]); w.z = cvt_pk_bf16(v1[0], v1[1]); w.w = cvt_pk_bf16(v1[2], v1[3]);
                    *(u32x4*)(rowp + bj * HALF) = w; } }
    }
};
__device__ __forceinline__ float silu_f(float x) { return x * __builtin_amdgcn_rcpf(1.0f + __builtin_amdgcn_exp2f(-1.4426950408889634f * x)); }
struct EpiMoeGU {
    static constexpr bool PERM = true, AFTER_DRAIN = false;
    bf16_t* H;
    __device__ __forceinline__ void operator()(const f32x4 (&acc)[2][2][4][2], const Unit& u, int wr, int wc, int fr, int fq) const {
        const int row0 = u.pm * BM + wr * 64 + fr, hc0 = (u.pn & 3) * 128 + wc * 32 + 8 * fq;
#pragma unroll
        for (int ai = 0; ai < 2; ++ai)
#pragma unroll
            for (int m = 0; m < 4; ++m) { bf16_t* rowp = H + (size_t)(row0 + ai * HALF + m * 16) * 512 + hc0;
                const f32x4 g0 = acc[ai][0][m][0], g1 = acc[ai][0][m][1], u0 = acc[ai][1][m][0], u1 = acc[ai][1][m][1];
                u32x4 w; w.x = cvt_pk_bf16(silu_f(g0[0]) * u0[0], silu_f(g0[1]) * u0[1]); w.y = cvt_pk_bf16(silu_f(g0[2]) * u0[2], silu_f(g0[3]) * u0[3]);
                w.z = cvt_pk_bf16(silu_f(g1[0]) * u1[0], silu_f(g1[1]) * u1[1]); w.w = cvt_pk_bf16(silu_f(g1[2]) * u1[2], silu_f(g1[3]) * u1[3]);
                *(u32x4*)rowp = w; }
    }
};
struct EpiMoeDown {
    static constexpr bool PERM = true, AFTER_DRAIN = false;
    bf16_t* F; const int* list; int T;
    __device__ __forceinline__ void operator()(const f32x4 (&acc)[2][2][4][2], const Unit& u, int wr, int wc, int fr, int fq) const {
        const int* lb = list + u.e * 16384 + u.mt * BM; const int col0 = (u.pn & 3) * BM + wc * 32 + 8 * fq;
#pragma unroll
        for (int ai = 0; ai < 2; ++ai)
#pragma unroll
            for (int m = 0; m < 4; ++m) { const int rl = ai * HALF + wr * 64 + m * 16 + fr;
                if (rl < u.nv) { const int ent = lb[rl]; bf16_t* rowp = F + ((size_t)(ent & 1) * T + (ent >> 1)) * 1024 + col0;
#pragma unroll
                    for (int bj = 0; bj < 2; ++bj) { const f32x4 v0 = acc[ai][bj][m][0], v1 = acc[ai][bj][m][1];
                        u32x4 w; w.x = cvt_pk_bf16(v0[0], v0[1]); w.y = cvt_pk_bf16(v0[2], v0[3]); w.z = cvt_pk_bf16(v1[0], v1[1]); w.w = cvt_pk_bf16(v1[2], v1[3]);
                        *(u32x4*)(rowp + bj * HALF) = w; } } }
    }
};
struct MoeOrder {
    const PG8_LAS int* cntl; const int* list; int G, c;
    __device__ __forceinline__ bool next(int i, Unit& u) const {
        const int L = i * G + c, tile = L >> 2; int acc = 0;
#pragma unroll 1
        for (int e = 0; e < 16; ++e) { const int ce = cntl[e], nte = (ce + BM - 1) >> 8;
            if (tile < acc + nte) { u.e = e; u.mt = tile - acc; u.pm = tile; u.pn = e * 4 + (L & 3); const int rem = ce - u.mt * BM; u.nv = rem < BM ? rem : BM; return true; }
            acc += nte; }
        return false;
    }
    __device__ __forceinline__ int gather_row(const Unit& u, int r) const { const int* lb = list + u.e * 16384 + u.mt * BM; return lb[r < u.nv ? r : 0] >> 1; }
    __device__ __forceinline__ void a_ready(const Unit&) const {}
    __device__ __forceinline__ void done(const Unit&) const {}
};

template <class Epi, class Sched, bool ALIGN_EPI, bool GATHER>
__device__ __forceinline__ void gemm_phase(PG8_LAS unsigned char* lds, const Gemm g, const Sched& S, const Epi& E, const int tid) {
    const int wid = __builtin_amdgcn_readfirstlane(tid >> 6), lane = tid & 63, wr = wid >> 2, wc = wid & 3, fr = lane & 15, fq = lane >> 4;
    const int K = g.K, nt = K / BK;
    unsigned voffB[2], vC[2][2], vN[2][2]; int stR[2], stC[2];
#pragma unroll
    for (int i = 0; i < 2; ++i) { int R, C; stage_rc(tid * 16 + i * 8192, R, C); stR[i] = R; stC[i] = C; const int Rb = Epi::PERM ? ((R & ~31) + perm32(R & 31)) : R;
        voffB[i] = (unsigned)(Rb * K + C) * 2u; }
    const size_t kstep = (size_t)(BK * 2);
    const size_t hstep = (size_t)HALF * K * 2;
    const size_t tstep = 2 * hstep;
    const unsigned ldsw = (unsigned)wid * 1024u;
    const int aoff = lds_byte(wr * 64 + fr, fq * 8), boff = lds_byte(wc * 32 + fr, fq * 8);
#define PG8_SA(b, h) (((b) * 2 + (h)) * HTB)
#define PG8_SB(b, h) ((4 + (b) * 2 + (h)) * HTB)
#define PG8_STAGE(bufoff, gbase, voff) do { _Pragma("unroll") for (int _i = 0; _i < 2; ++_i) \
        __builtin_amdgcn_global_load_lds((const unsigned*)((const char*)(gbase) + (voff)[_i]), (PG8_LAS unsigned*)(lds + (bufoff) + ldsw + _i * 8192), 16, 0, 0); } while (0)
#define PG8_LDA(dst, b, h) do { _Pragma("unroll") for (int m = 0; m < 4; ++m) _Pragma("unroll") for (int k = 0; k < 2; ++k) dst[m][k] = *(const PG8_LAS bf16x8*)(lds + PG8_SA(b, h) + aoff + m * 2048 + k * 1024); } while (0)
#define PG8_LDB(dst, b, h) do { _Pragma("unroll") for (int n = 0; n < 2; ++n) _Pragma("unroll") for (int k = 0; k < 2; ++k) dst[n][k] = *(const PG8_LAS bf16x8*)(lds + PG8_SB(b, h) + boff + n * 2048 + k * 1024); } while (0)
#define PG8_MMA(ai, bj, At, Bt) do { __builtin_amdgcn_s_setprio(1); _Pragma("unroll") for (int m = 0; m < 4; ++m) _Pragma("unroll") for (int n = 0; n < 2; ++n) _Pragma("unroll") for (int k = 0; k < 2; ++k) \
        acc[ai][bj][m][n] = __builtin_amdgcn_mfma_f32_16x16x32_bf16(Bt[n][k], At[m][k], acc[ai][bj][m][n], 0, 0, 0); __builtin_amdgcn_s_setprio(0); } while (0)
#define PG8_WAIT_V(n) asm volatile("s_waitcnt vmcnt(" #n ")" ::: "memory")
#define PG8_WAIT_L(n) asm volatile("s_waitcnt lgkmcnt(" #n ")" ::: "memory")
#define PG8_BAR __builtin_amdgcn_s_barrier()
#define PG8_SCHED __builtin_amdgcn_sched_barrier(0)
#define PG8_SETV(v, u) do { _Pragma("unroll") for (int _h = 0; _h < 2; ++_h) _Pragma("unroll") for (int _i = 0; _i < 2; ++_i) { \
        if constexpr (GATHER) { const int _tok = S.gather_row(u, _h * HALF + stR[_i]); v[_h][_i] = (unsigned)(_tok * K + stC[_i]) * 2u; } \
        else v[_h][_i] = (unsigned)((_h * HALF + stR[_i]) * K + stC[_i]) * 2u; } } while (0)
#define PG8_STAGE_SEL(bufoff, gbase, h) do { _Pragma("unroll") for (int _i = 0; _i < 2; ++_i) { const unsigned _o = (GATHER && last) ? vN[h][_i] : vC[h][_i]; \
        __builtin_amdgcn_global_load_lds((const unsigned*)((const char*)(gbase) + _o), (PG8_LAS unsigned*)(lds + (bufoff) + ldsw + _i * 8192), 16, 0, 0); } } while (0)
    Unit cur, nxt; int ui = 0;
    if (!S.next(0, cur)) return;
    f32x4 acc[2][2][4][2];
#pragma unroll
    for (int a = 0; a < 2; ++a)
#pragma unroll
        for (int b = 0; b < 2; ++b)
#pragma unroll
            for (int m = 0; m < 4; ++m)
#pragma unroll
                for (int n = 0; n < 2; ++n) acc[a][b][m][n] = (f32x4){0.f, 0.f, 0.f, 0.f};
    bf16x8 At[4][2], B0[2][2], B1[2][2];
    PG8_SETV(vC, cur);
    if constexpr (GATHER) asm volatile("s_waitcnt vmcnt(0)" : "+v"(vC[0][0]), "+v"(vC[0][1]), "+v"(vC[1][0]), "+v"(vC[1][1]) :: "memory");
    const char* cA = GATHER ? (const char*)g.A : (const char*)g.A + (size_t)cur.pm * tstep; const char* cB = (const char*)g.Bt + (size_t)cur.pn * tstep;
    S.a_ready(cur);
    PG8_STAGE(PG8_SB(0, 0), cB, voffB); PG8_STAGE(PG8_SB(0, 1), cB + hstep, voffB); PG8_STAGE(PG8_SA(0, 0), cA, vC[0]); PG8_STAGE(PG8_SA(0, 1), cA, vC[1]);
    if (wr == 1) PG8_BAR;
    PG8_WAIT_V(2); PG8_BAR;
    PG8_STAGE(PG8_SB(1, 0), cB + kstep, voffB); PG8_STAGE(PG8_SA(1, 0), cA + kstep, vC[0]); PG8_STAGE(PG8_SB(1, 1), cB + hstep + kstep, voffB);
    PG8_WAIT_V(6); PG8_BAR;
    for (;;) {
        const bool has_next = S.next(ui + 1, nxt);
        if constexpr (GATHER) {
            if (has_next) { PG8_SETV(vN, nxt); asm volatile("s_waitcnt vmcnt(0)" : "+v"(vN[0][0]), "+v"(vN[0][1]), "+v"(vN[1][0]), "+v"(vN[1][1]) :: "memory"); }
            else {
#pragma unroll
                for (int h = 0; h < 2; ++h)
#pragma unroll
                    for (int i = 0; i < 2; ++i) vN[h][i] = vC[h][i]; }
        }
        const char* nA = GATHER ? cA : (has_next ? (const char*)g.A + (size_t)nxt.pm * tstep : cA); const char* nB = has_next ? (const char*)g.Bt + (size_t)nxt.pn * tstep : cB;
        for (int t = 0; t < nt; t += 2) {
            const bool last = (t == nt - 2);
            const char* a1 = cA + (size_t)(t + 1) * kstep;
            const char* a2 = last ? nA : cA + (size_t)(t + 2) * kstep; const char* b2 = last ? nB : cB + (size_t)(t + 2) * kstep;
            const char* a3 = a2 + kstep; const char* b3 = b2 + kstep;
            if (last && has_next) S.a_ready(nxt);
            PG8_LDB(B0, 0, 0); PG8_LDB(B1, 0, 1); PG8_SCHED; PG8_LDA(At, 0, 0); PG8_STAGE(PG8_SA(1, 1), a1, vC[1]);
            PG8_WAIT_V(8); PG8_WAIT_L(0); PG8_BAR; PG8_MMA(0, 0, At, B0); PG8_MMA(0, 1, At, B1); PG8_BAR; PG8_SCHED;
            PG8_LDA(At, 0, 1); PG8_STAGE(PG8_SB(0, 0), b2, voffB); PG8_STAGE(PG8_SB(0, 1), b2 + hstep, voffB); PG8_STAGE_SEL(PG8_SA(0, 0), a2, 0);
            PG8_WAIT_V(8); PG8_WAIT_L(0); PG8_BAR; PG8_MMA(1, 0, At, B0); PG8_MMA(1, 1, At, B1); PG8_BAR; PG8_SCHED;
            PG8_LDB(B0, 1, 0); PG8_LDB(B1, 1, 1); PG8_SCHED; PG8_LDA(At, 1, 0); PG8_STAGE_SEL(PG8_SA(0, 1), a2, 1);
            PG8_WAIT_V(8); PG8_WAIT_L(0); PG8_BAR; PG8_MMA(0, 0, At, B0); PG8_MMA(0, 1, At, B1); PG8_BAR; PG8_SCHED;
            PG8_LDA(At, 1, 1); PG8_STAGE(PG8_SB(1, 0), b3, voffB); PG8_STAGE(PG8_SB(1, 1), b3 + hstep, voffB); PG8_STAGE_SEL(PG8_SA(1, 0), a3, 0);
            PG8_WAIT_V(8); PG8_WAIT_L(0); PG8_BAR; PG8_MMA(1, 0, At, B0); PG8_MMA(1, 1, At, B1); PG8_BAR; PG8_SCHED;
        }
        if constexpr (ALIGN_EPI) { if (wr == 0) PG8_BAR; }
        E(acc, cur, wr, wc, fr, fq); S.done(cur);
        if (!has_next) break;
#pragma unroll
        for (int a = 0; a < 2; ++a)
#pragma unroll
            for (int b = 0; b < 2; ++b)
#pragma unroll
                for (int m = 0; m < 4; ++m)
#pragma unroll
                    for (int n = 0; n < 2; ++n) acc[a][b][m][n] = (f32x4){0.f, 0.f, 0.f, 0.f};
        cur = nxt; cA = nA; cB = nB; ++ui;
        if constexpr (GATHER) {
#pragma unroll
            for (int h = 0; h < 2; ++h)
#pragma unroll
                for (int i = 0; i < 2; ++i) vC[h][i] = vN[h][i]; }
        if constexpr (ALIGN_EPI) { if (wr == 1) PG8_BAR; }
    }
    PG8_WAIT_V(0);
    if constexpr (!ALIGN_EPI) { if (wr == 0) PG8_BAR; }
    PG8_BAR;
#undef PG8_SA
#undef PG8_SB
#undef PG8_STAGE
#undef PG8_LDA
#undef PG8_LDB
#undef PG8_MMA
#undef PG8_WAIT_V
#undef PG8_WAIT_L
#undef PG8_BAR
#undef PG8_SCHED
#undef PG8_SETV
#undef PG8_STAGE_SEL
}
}
#define GAS __attribute__((address_space(1)))
#define LAS __attribute__((address_space(3)))
typedef unsigned short bf16;
typedef unsigned v4u __attribute__((ext_vector_type(4)));
typedef float f32x4 __attribute__((ext_vector_type(4)));
typedef short bf16x8 __attribute__((ext_vector_type(8)));
typedef GAS unsigned gu32;
typedef GAS unsigned long long gu64;
#define RLX_AGENT __ATOMIC_RELAXED, __HIP_MEMORY_SCOPE_AGENT
#define LDS_WAIT() asm volatile("s_waitcnt lgkmcnt(0)" ::: "memory")
#define VM_WAIT() asm volatile("s_waitcnt vmcnt(0)" ::: "memory")
__device__ __forceinline__ unsigned long long rt() { return __builtin_amdgcn_s_memrealtime(); }
__device__ __forceinline__ unsigned f2bf(float f) { unsigned u = __builtin_bit_cast(unsigned, f); return (u + 0x7fffu + ((u >> 16) & 1u)) >> 16; }
__device__ __forceinline__ unsigned pk2(float lo, float hi) { return f2bf(lo) | (f2bf(hi) << 16); }

#define XB_TMO      128
#define XB_XCNT(j)  (256  + 64 * (j))
#define XB_XSUB(j)  (1280 + 64 * (j))
#define XB_XGEN(j)  (2304 + 64 * (j))
#define XB_TOP      3328
#define XB_TOPGEN   3392
#define XCD_BAR_WORDS 3456
#define XB_SPIN_CAP (1u << 18)

__device__ __forceinline__ unsigned xb_ld(unsigned* p)              { return __hip_atomic_load(p, __ATOMIC_RELAXED, __HIP_MEMORY_SCOPE_AGENT); }
__device__ __forceinline__ unsigned xb_add(unsigned* p, unsigned v) { return __hip_atomic_fetch_add(p, v, __ATOMIC_RELAXED, __HIP_MEMORY_SCOPE_AGENT); }
__device__ __forceinline__ unsigned xb_xcc_id() { return (unsigned)__builtin_amdgcn_s_getreg((3 << 11) | 20) & 0xFu; }
#define XB_SPIN(cond, bar) do { unsigned _sp = 0; while (cond) { __builtin_amdgcn_s_sleep(1); \
    if ((++_sp & 255u) == 0u) { if (xb_ld(&(bar)[XB_TMO])) break; if (_sp > XB_SPIN_CAP) { atomicAdd(&(bar)[XB_TMO], 1u); break; } } } } while (0)

struct XcdBarrier {
    unsigned* bar; unsigned x;
    volatile LAS unsigned* st;
};

__device__ __forceinline__ XcdBarrier xcd_barrier_post(unsigned* bar, volatile LAS unsigned* st) {
    XcdBarrier b; b.bar = bar; b.x = xb_xcc_id(); b.st = st;
    if (threadIdx.x == 0) (void)xb_add(&bar[XB_XCNT(b.x)], 1u);
    return b;
}
__device__ __forceinline__ void xcd_barrier_complete(unsigned* bar, unsigned x, unsigned& nloc, unsigned& nx) {
    const unsigned G = gridDim.x * gridDim.y * gridDim.z;
    unsigned sum, cnt, mine, sp = 0u;
    for (;;) {
        sum = 0u; cnt = 0u; mine = 0u;
#pragma unroll
        for (unsigned j = 0; j < 16; ++j) { const unsigned c = xb_ld(&bar[XB_XCNT(j)]); sum += c; cnt += (c > 0u) ? 1u : 0u; mine = (j == x) ? c : mine; }
        if (sum == G) break;
        __builtin_amdgcn_s_sleep(1);
        if ((++sp & 255u) == 0u) { if (xb_ld(&bar[XB_TMO])) break; if (sp > XB_SPIN_CAP) { atomicAdd(&bar[XB_TMO], 1u); break; } }
    }
    nloc = mine > 0u ? mine : 1u; nx = cnt > 0u ? cnt : 1u;
}

__device__ __forceinline__ void xcd_barrier(const XcdBarrier& b) {
    asm volatile("s_waitcnt vmcnt(0)" ::: "memory");
    __syncthreads();
    if (threadIdx.x == 0) {
        unsigned* bar = b.bar;
        __builtin_amdgcn_s_waitcnt(0);
        unsigned nloc = b.st[0], nx = b.st[1];
        if (nloc == 0u) { xcd_barrier_complete(bar, b.x, nloc, nx); b.st[0] = nloc; b.st[1] = nx; }
        const unsigned old = xb_add(&bar[XB_XSUB(b.x)], 1u);
        const unsigned gen = old / nloc;
        if (old + 1u == (gen + 1u) * nloc) {
            __builtin_amdgcn_fence(__ATOMIC_RELEASE, "agent");
            asm volatile("s_waitcnt vmcnt(0)" ::: "memory");
            const unsigned og = xb_add(&bar[XB_TOP], 1u);
            const unsigned tg = og / nx;
            if (og + 1u == (tg + 1u) * nx) xb_add(&bar[XB_TOPGEN], 1u);
            else XB_SPIN(xb_ld(&bar[XB_TOPGEN]) == tg, bar);
            __builtin_amdgcn_fence(__ATOMIC_ACQUIRE, "agent");
            xb_add(&bar[XB_XGEN(b.x)], 1u);
            asm volatile("s_waitcnt vmcnt(0)" ::: "memory");
        } else {
            XB_SPIN(xb_ld(&bar[XB_XGEN(b.x)]) == gen, bar);
            __builtin_amdgcn_fence(__ATOMIC_ACQUIRE, "agent");
            asm volatile("s_waitcnt vmcnt(0)" ::: "memory");
        }
    }
    __syncthreads();
}

constexpr int T = 16384, D = 1024, SEQ = 4096, NB = 4, INW = 5376, NL = 4;
constexpr int C_Q = 0, C_K = 1024, C_V = 1152, C_LX = 1280, C_LG = 2304, C_GA = 3328, C_GB = 4352;
constexpr int NE = 16, FF = 512;
constexpr float ALPHA = 1.681792830507429f;
constexpr float LN_EPS = 1e-5f;
constexpr float LOG2E = 1.4426950408889634f;
constexpr size_t MiB = 1u << 20;
constexpr size_t WS_CTL = 0, CTL_ZERO_BYTES = 1 * MiB;
constexpr int CW_TMO = 0, CW_BAR = 4096, CW_CNT = 16384;
constexpr size_t WS_MOD = 1 * MiB;
constexpr size_t WS_SUM = 2 * MiB;
constexpr size_t WS_EIDX = 3 * MiB;
constexpr size_t WS_EW = 3 * MiB + 512 * 1024;
constexpr size_t WS_LIST = 4 * MiB;
constexpr size_t WS_LRUW = 5 * MiB;
constexpr size_t WS_WIN = 6 * MiB;
constexpr size_t WS_WO = 17 * MiB;
constexpr size_t WS_WGU = 19 * MiB;
constexpr size_t WS_WD = 51 * MiB;
constexpr size_t WS_U = 68 * MiB;
constexpr size_t WS_P = 100 * MiB;
constexpr size_t WS_Y = 268 * MiB;
constexpr size_t WS_H = 300 * MiB;
constexpr size_t WS_YP = 336 * MiB;
constexpr size_t WS_END = 368 * MiB;
constexpr size_t WS_TA = 368 * MiB, WS_TI = 432 * MiB, WS_TZ = 496 * MiB, WS_END_HYB = 560 * MiB;

constexpr int NWAVES = 8;
constexpr int RING_OFF = 0, RING_BYTES = 131072;
constexpr int LDSCTL_OFF = 147456 - 1024;
constexpr int LDS_BYTES = 147456;

typedef float f32x16 __attribute__((ext_vector_type(16)));
typedef unsigned u32x2 __attribute__((ext_vector_type(2)));
#define LD16(base, off) (*(const unsigned short*)((const char*)(base) + (off)))
__device__ __forceinline__ float bf2f(unsigned v) { return __uint_as_float(v << 16); }
__device__ __forceinline__ float fast_sigmoid(float x) { return __builtin_amdgcn_rcpf(1.0f + __builtin_amdgcn_exp2f(-LOG2E * x)); }
__device__ __forceinline__ float gelu_tanh_f(float x) { const float u = 0.7978845608028654f * (x + 0.044715f * x * x * x); return x * fast_sigmoid(2.0f * u); }
template <int CTRL, int ROW_MASK>
__device__ __forceinline__ float dpp_add(float v) {
    return v + __int_as_float(__builtin_amdgcn_update_dpp(0, __float_as_int(v), CTRL, ROW_MASK, 0xF, false)); }
__device__ __forceinline__ float wave_sum(float v) {
    v = dpp_add<0xB1, 0xF>(v);
    v = dpp_add<0x4E, 0xF>(v);
    v = dpp_add<0x141, 0xF>(v);
    v = dpp_add<0x140, 0xF>(v);
    v = dpp_add<0x142, 0xA>(v);
    v = dpp_add<0x143, 0xC>(v);
    return __int_as_float(__builtin_amdgcn_readlane(__float_as_int(v), 63));
}
__constant__ int c_bucket[128] = {0, 1, 2, 3, 4, 5, 6, 7, 8, 9, 10, 11, 12, 13, 14, 15, 16, 16, 16, 17, 17, 18, 18, 18, 19, 19, 19, 20, 20, 20, 20, 21, 21, 21, 21, 22, 22, 22, 22, 22, 23, 23, 23, 23, 23, 23, 24, 24, 24, 24, 24, 24, 25, 25, 25, 25, 25, 25, 25, 26, 26, 26, 26, 26, 26, 26, 26, 27, 27, 27, 27, 27, 27, 27, 27, 27, 27, 28, 28, 28, 28, 28, 28, 28, 28, 28, 28, 29, 29, 29, 29, 29, 29, 29, 29, 29, 29, 29, 29, 30, 30, 30, 30, 30, 30, 30, 30, 30, 30, 30, 30, 30, 30, 31, 31, 31, 31, 31, 31, 31, 31, 31, 31, 31, 31, 31, 31, 31};

struct Ptrs {
    const float *x, *c, *ada_w, *ada_b, *w_in, *attn_sink, *rel_bias, *conv_w, *conv_b, *lru_wa, *lru_ba, *lru_wx, *lru_bx, *lru_lambda, *w_out, *ln1_g, *ln1_b, *router_w, *router_b, *moe_wg, *moe_wu, *moe_wd, *ln2_g, *ln2_b;
    float* out; unsigned char* ws;
};

__device__ __forceinline__ void transpose_item(const float* W, int K, int N, bf16* WT, int row_off, int item, int lane) {
    const int nblk = N / 32, kbi = item / nblk, nb = item % nblk, k0 = 64 * kbi + 8 * (lane >> 3), n0 = 32 * nb + 4 * (lane & 7);
    f32x4 v[8];
#pragma unroll
    for (int i = 0; i < 8; ++i) v[i] = *(const f32x4*)(W + (size_t)(k0 + i) * N + n0);
#pragma unroll
    for (int j = 0; j < 4; ++j) { v4u o; o.x = pk2(v[0][j], v[1][j]); o.y = pk2(v[2][j], v[3][j]); o.z = pk2(v[4][j], v[5][j]); o.w = pk2(v[6][j], v[7][j]);
        *(GAS v4u*)(WT + (size_t)(row_off + n0 + j) * K + k0) = o; }
}
__device__ __forceinline__ void convert_layer(const Ptrs& p, int l, LAS unsigned char* lds, int gw, int NGW, int wave, int lane) {
    (void)lds; (void)wave;
    constexpr int I_IN = (D / 64) * (INW / 32), I_O = (D / 64) * (D / 32), I_GU = 2 * NE * 256, I_D = NE * 256, I_L = 128;
    constexpr int NITEMS = I_IN + I_O + I_GU + I_D + I_L;
    bf16* WinT = (bf16*)(p.ws + WS_WIN); bf16* WoT = (bf16*)(p.ws + WS_WO); bf16* WguT = (bf16*)(p.ws + WS_WGU); bf16* WdT = (bf16*)(p.ws + WS_WD); bf16* waT = (bf16*)(p.ws + WS_LRUW); bf16* wxT = waT + 8 * 128 * 128;
    for (int it = gw; it < NITEMS; it += NGW) {
        int r = it;
        if (r < I_IN) { transpose_item(p.w_in + (size_t)l * D * INW, D, INW, WinT, 0, r, lane); continue; } r -= I_IN;
        if (r < I_O) { transpose_item(p.w_out + (size_t)l * D * D, D, D, WoT, 0, r, lane); continue; } r -= I_O;
        if (r < I_GU) { const int mat = r / (NE * 256); const int q = r % (NE * 256); const int e = q / 256, ti = q % 256; const int n0 = 32 * (ti % 16);
            const float* W = (mat ? p.moe_wu : p.moe_wg) + ((size_t)l * NE + e) * D * FF;
            transpose_item(W, D, FF, WguT, e * 1024 + (n0 / 128) * 256 + mat * 128 + (n0 % 128) - n0, ti, lane); continue; } r -= I_GU;
        if (r < I_D) { const int e = r / 256, ti = r % 256; transpose_item(p.moe_wd + ((size_t)l * NE + e) * FF * D, FF, D, WdT, e * 1024, ti, lane); continue; } r -= I_D;
        { const int mat = r / 64; const int q = r % 64; const int hb = q / 8, ti = q % 8;
            transpose_item((mat ? p.lru_wx : p.lru_wa) + ((size_t)l * 8 + hb) * 128 * 128, 128, 128, mat ? wxT : waT, hb * 128, ti, lane); }
    }
}
__device__ __forceinline__ void mod_item(const Ptrs& p, int item, LAS unsigned char* lds, int tid, int wave, int lane) {
    LAS float* ca = (LAS float*)lds;
    LAS float* red = (LAS float*)(lds + 16384);
    const int l = item / 24, j0 = (item % 24) * 256;
    for (int i = tid; i < NB * D; i += 512) { const float v = p.c[i]; ca[i] = v * fast_sigmoid(v); }
    __syncthreads();
    f32x4 acc[NB];
#pragma unroll
    for (int b = 0; b < NB; ++b) acc[b] = (f32x4){0.f, 0.f, 0.f, 0.f};
    const float* w = p.ada_w + (size_t)l * D * 6144 + j0 + 4 * lane;
#pragma unroll 8
    for (int kk = 0; kk < 128; ++kk) { const int k = wave * 128 + kk; const f32x4 wv = *(const f32x4*)(w + (size_t)k * 6144);
#pragma unroll
        for (int b = 0; b < NB; ++b) acc[b] += wv * ca[b * D + k]; }
#pragma unroll
    for (int b = 0; b < NB; ++b) *(LAS f32x4*)(red + (wave * NB + b) * 256 + 4 * lane) = acc[b];
    __syncthreads();
    float* mod = (float*)(p.ws + WS_MOD);
    for (int i = tid; i < NB * 256; i += 512) { const int b = i / 256, jj = i % 256; float s = 0.f;
#pragma unroll
        for (int w8 = 0; w8 < 8; ++w8) s += red[(w8 * NB + b) * 256 + jj];
        mod[((size_t)l * NB + b) * 6144 + j0 + jj] = s + p.ada_b[l * 6144 + j0 + jj]; }
    __syncthreads();
}
__device__ __forceinline__ void modulate_rows(const float* x, const float* mod_l, bf16* U, int gw, int NGW, int lane) {
    for (int row = gw; row < T; row += NGW) { const float* m = mod_l + (size_t)(row / SEQ) * 6144;
#pragma unroll
        for (int j = 0; j < 4; ++j) { const int col = 4 * lane + 256 * j; const f32x4 xv = *(const f32x4*)(x + (size_t)row * D + col), sh = *(const f32x4*)(m + col), sc = *(const f32x4*)(m + 1024 + col);
            const f32x4 u = xv * (sc + 1.0f) + sh; u32x2 o; o.x = pk2(u[0], u[1]); o.y = pk2(u[2], u[3]); *(u32x2*)(U + (size_t)row * D + col) = o; } }
}

constexpr int XC_STRIDE = 272;
constexpr int LX_XC = 0, LX_END = 4 * 128 * XC_STRIDE;
__device__ __forceinline__ void phase_lru(const Ptrs& p, int l, LAS unsigned char* lds, int vcu, int G) {
    const bf16* P = (const bf16*)(p.ws + WS_P); bf16* YL = (bf16*)(p.ws + WS_Y); bf16* YP = (bf16*)(p.ws + WS_YP);
    float* SA = (float*)(p.ws + WS_SUM); float* SB = SA + NB * 32 * 1024;
    const bf16* waT = (const bf16*)(p.ws + WS_LRUW); const bf16* wxT = waT + 8 * 128 * 128;
    for (int unit = vcu; unit < 256; unit += G) {
        int tid = threadIdx.x; asm volatile("" : "+v"(tid));
        const int lane = tid & 63, w = __builtin_amdgcn_readfirstlane(tid >> 6), l31 = lane & 31, hi = lane >> 5;
        const int b = unit >> 6, n = (unit & 63) >> 1, half = unit & 1;
        const int row0 = b * SEQ + n * 128;
        __syncthreads();
        { const int tg = tid >> 6, cg = tid & 63, chc = half * 512 + 8 * cg;
            f32x4 cwv[5][2];
#pragma unroll
            for (int q = 0; q < 4; ++q) { cwv[q][0] = *(const f32x4*)(p.conv_w + ((size_t)l * 4 + q) * D + chc); cwv[q][1] = *(const f32x4*)(p.conv_w + ((size_t)l * 4 + q) * D + chc + 4); }
            cwv[4][0] = *(const f32x4*)(p.conv_b + l * D + chc); cwv[4][1] = *(const f32x4*)(p.conv_b + l * D + chc + 4);
#pragma unroll
            for (int pp = 0; pp < 4; ++pp) { const int t0 = row0 + 32 * pp + 4 * tg;
                v4u xr[7];
#pragma unroll
                for (int i = 0; i < 7; ++i) { xr[i] = (v4u){0u, 0u, 0u, 0u}; if (n > 0 || pp > 0 || tg > 0 || i >= 3) xr[i] = *(const v4u*)(P + (size_t)(t0 - 3 + i) * INW + C_LX + chc); }
#pragma unroll
                for (int k = 0; k < 4; ++k) { v4u o;
#pragma unroll
                    for (int d2 = 0; d2 < 4; ++d2) { float r2[2];
#pragma unroll
                        for (int e = 0; e < 2; ++e) { const int cc = 2 * d2 + e; float acc = cwv[4][cc >> 2][cc & 3];
#pragma unroll
                            for (int q = 0; q < 4; ++q) { const unsigned wd = xr[k + q][d2]; acc += cwv[q][cc >> 2][cc & 3] * (e ? bf2f(wd >> 16) : bf2f(wd & 0xffffu)); }
                            r2[e] = acc; }
                        o[d2] = pk2(r2[0], r2[1]); }
                    *(LAS v4u*)(lds + LX_XC + (cg >> 4) * (128 * XC_STRIDE) + (32 * pp + 4 * tg + k) * XC_STRIDE + (cg & 15) * 16) = o; } } }
        __syncthreads();
        const int hbl = w >> 1, jb = (w & 1) * 64, hb = half * 4 + hbl;
#pragma unroll 1
        for (int dh = 0; dh < 2; ++dh) {
            const int jcol = jb + dh * 32 + l31, col = hb * 128 + jcol;
            const float ba_v = p.lru_ba[l * D + col], bx_v = p.lru_bx[l * D + col];
            const float kk_v = -8.0f * log1pf(__expf(-p.lru_lambda[l * D + col]));
            bf16x8 bwa[8], bwx[8];
#pragma unroll
            for (int ks = 0; ks < 8; ++ks) { bwa[ks] = *(const bf16x8*)(waT + ((size_t)hb * 128 + jcol) * 128 + 8 * hi + 16 * ks); bwx[ks] = *(const bf16x8*)(wxT + ((size_t)hb * 128 + jcol) * 128 + 8 * hi + 16 * ks); }
            float hrun = 0.f, prun = 1.f;
#pragma unroll 1
            for (int c = 0; c < 4; ++c) {
                f32x16 ra = (f32x16){}, ia = (f32x16){};
                const LAS unsigned char* xt = lds + LX_XC + hbl * (128 * XC_STRIDE) + (32 * c) * XC_STRIDE;
#pragma unroll
                for (int ks = 0; ks < 8; ++ks) { const bf16x8 af = *(const LAS bf16x8*)(xt + l31 * XC_STRIDE + (16 * ks + 8 * hi) * 2);
                    ra = __builtin_amdgcn_mfma_f32_32x32x16_bf16(af, bwa[ks], ra, 0, 0, 0); ia = __builtin_amdgcn_mfma_f32_32x32x16_bf16(af, bwx[ks], ia, 0, 0, 0); }
                const unsigned rb = (unsigned)(row0 + 32 * c + 4 * hi), offP = (rb * INW + col) * 2u, offY = (rb * D + col) * 2u;
                unsigned short lgv[16], gbv[16];
#pragma unroll
                for (int r = 0; r < 16; ++r) { const unsigned rk = (r & 3) + 8 * (r >> 2); lgv[r] = LD16(P, offP + C_LG * 2 + rk * (INW * 2)); gbv[r] = LD16(P, offP + C_GB * 2 + rk * (INW * 2)); }
                float av[16], bv[16];
                const LAS unsigned short* xcol = (const LAS unsigned short*)xt + jcol;
#pragma unroll
                for (int r = 0; r < 16; ++r) { const int tok = (r & 3) + 8 * (r >> 2) + 4 * hi;
                    const float rr = fast_sigmoid(ra[r] + ba_v), ii = fast_sigmoid(ia[r] + bx_v);
                    const float la = kk_v * rr;
                    const float a = __builtin_amdgcn_exp2f(la * LOG2E);
                    const float e2 = 2.0f * la;
                    const float om = (e2 > -0.1f) ? -e2 * (1.0f + e2 * (0.5f + e2 * (0.16666667f + e2 * 0.041666668f))) : 1.0f - a * a;
                    const float xc = bf2f(xcol[tok * (XC_STRIDE / 2)]);
                    av[r] = a; bv[r] = __builtin_sqrtf(om) * (ii * xc); }
                float Ag[4], Bg[4], Ap[4], Bp[4];
#pragma unroll
                for (int g = 0; g < 4; ++g) { float A = av[4 * g], B = bv[4 * g];
#pragma unroll
                    for (int e = 1; e < 4; ++e) { B = av[4 * g + e] * B + bv[4 * g + e]; A *= av[4 * g + e]; }
                    Ag[g] = A; Bg[g] = B; Ap[g] = __shfl_xor(A, 32); Bp[g] = __shfl_xor(B, 32); }
                float hs = hrun, ps = prun, stt[4], ptt[4];
#pragma unroll
                for (int g = 0; g < 4; ++g) { const float A0 = hi ? Ap[g] : Ag[g], B0 = hi ? Bp[g] : Bg[g], A1 = hi ? Ag[g] : Ap[g], B1 = hi ? Bg[g] : Bp[g];
                    const float s0 = hs, q0 = ps; hs = A0 * hs + B0; ps *= A0; const float s1 = hs, q1 = ps; hs = A1 * hs + B1; ps *= A1; stt[g] = hi ? s1 : s0; ptt[g] = hi ? q1 : q0; }
                hrun = hs; prun = ps;
#pragma unroll
                for (int g = 0; g < 4; ++g) { float h = stt[g], pc = ptt[g];
#pragma unroll
                    for (int e = 0; e < 4; ++e) { const int r = 4 * g + e; h = av[r] * h + bv[r]; pc *= av[r];
                        const float lg = bf2f(lgv[r]), gb = bf2f(gbv[r]);
                        const float u2 = 1.5957691216057308f * (lg + 0.044715f * lg * lg * lg);
                        const float gg = lg * __builtin_amdgcn_rcpf((1.0f + __builtin_amdgcn_exp2f(-LOG2E * gb)) * (1.0f + __builtin_amdgcn_exp2f(-LOG2E * u2)));
                        const unsigned o = offY + ((r & 3) + 8 * (r >> 2)) * (D * 2);
                        *(unsigned short*)((char*)YL + o) = (unsigned short)f2bf(gg * h); *(unsigned short*)((char*)YP + o) = (unsigned short)f2bf(gg * pc); } }
            }
            if (hi == 0) { const size_t o = ((size_t)b * 32 + n) * 1024 + col; SA[o] = prun; SB[o] = hrun; }
        }
    }
}

constexpr int KS_STRIDE = 144;
constexpr int VT_STRIDE = 520;
constexpr int LB_K = 0, LB_V = 256 * KS_STRIDE  , LB_TBL = LB_V + 64 * VT_STRIDE  , LB_CARRY = LB_TBL + 8 * 192 * 4  , LB_END = LB_CARRY + 2048;
static_assert(LB_END <= RING_BYTES && LX_END <= LDSCTL_OFF, "phase B LDS");
__device__ __forceinline__ void phase_attn(const Ptrs& p, int l, LAS unsigned char* lds, int vcu, int G) {
    const bf16* P = (const bf16*)(p.ws + WS_P); bf16* Y = (bf16*)(p.ws + WS_Y); const bf16* YP = (const bf16*)(p.ws + WS_YP);
    const float* SA = (const float*)(p.ws + WS_SUM); const float* SB = SA + NB * 32 * 1024;
    for (int unit = vcu; unit < 256; unit += G) {
        int tid = threadIdx.x; asm volatile("" : "+v"(tid));
        const int lane = tid & 63, w = __builtin_amdgcn_readfirstlane(tid >> 6), l31 = lane & 31, hi = lane >> 5;
        const int b = unit >> 6, n = (unit & 63) >> 1, half = unit & 1;
        const int row0 = b * SEQ + n * 128;
        __syncthreads();
#pragma unroll
        for (int it = 0; it < 4; ++it) { const int idx = it * 512 + tid, r = idx >> 3, ch = idx & 7;
            v4u v = (v4u){0u, 0u, 0u, 0u};
            if (n > 0 || r >= 128) v = *(const v4u*)(P + (size_t)(row0 - 128 + r) * INW + C_K + half * 64 + ch * 8);
            *(LAS v4u*)(lds + LB_K + r * KS_STRIDE + ch * 16) = v; }
        { const int kg = tid >> 3, dc = tid & 7; v4u v[4];
#pragma unroll
            for (int i = 0; i < 4; ++i) { const int r = 4 * kg + i; v[i] = (v4u){0u, 0u, 0u, 0u};
                if (n > 0 || r >= 128) v[i] = *(const v4u*)(P + (size_t)(row0 - 128 + r) * INW + C_V + half * 64 + dc * 8); }
#pragma unroll
            for (int d2 = 0; d2 < 4; ++d2) {
                const unsigned a0 = v[0][d2], a1 = v[1][d2], a2 = v[2][d2], a3 = v[3][d2];
                u32x2 lo, hh; lo.x = (a0 & 0xffffu) | (a1 << 16); lo.y = (a2 & 0xffffu) | (a3 << 16); hh.x = (a0 >> 16) | (a1 & 0xffff0000u); hh.y = (a2 >> 16) | (a3 & 0xffff0000u);
                *(LAS u32x2*)(lds + LB_V + (dc * 8 + 2 * d2) * VT_STRIDE + kg * 8) = lo; *(LAS u32x2*)(lds + LB_V + (dc * 8 + 2 * d2 + 1) * VT_STRIDE + kg * 8) = hh; } }
#pragma unroll
        for (int i = 0; i < 3; ++i) { const int idx = tid + 512 * i, hd = idx / 192, xi = idx % 192, xx = xi - 32;
            float v = -INFINITY; if (xx >= 0 && xx < 128) v = p.rel_bias[c_bucket[127 - xx] * 16 + half * 8 + hd] * LOG2E;
            ((LAS float*)(lds + LB_TBL))[idx] = v; }
        {
            const size_t o0 = (size_t)b * 32 * 1024 + half * 512 + tid; float h = 0.f; int q = 0;
            for (; q + 8 <= n; q += 8) { float a8[8], b8[8];
#pragma unroll
                for (int u = 0; u < 8; ++u) { a8[u] = SA[o0 + (size_t)(q + u) * 1024]; b8[u] = SB[o0 + (size_t)(q + u) * 1024]; }
#pragma unroll
                for (int u = 0; u < 8; ++u) h = a8[u] * h + b8[u]; }
            for (; q < n; ++q) h = SA[o0 + (size_t)q * 1024] * h + SB[o0 + (size_t)q * 1024];
            ((LAS float*)(lds + LB_CARRY))[tid] = h; }
        __syncthreads();
        const int hq = half * 8 + w;
        const float sink2 = p.attn_sink[l * 16 + hq] * LOG2E;
        const float cy0 = ((const LAS float*)(lds + LB_CARRY))[w * 64 + l31], cy1 = ((const LAS float*)(lds + LB_CARRY))[w * 64 + 32 + l31];
#pragma unroll 1
        for (int c = 0; c < 4; ++c) {
            bf16x8 qr[4];
#pragma unroll
            for (int ks = 0; ks < 4; ++ks) qr[ks] = *(const bf16x8*)(P + (size_t)(row0 + 32 * c + l31) * INW + C_Q + hq * 64 + 16 * ks + 8 * hi);
            f32x16 st[5];
#pragma unroll
            for (int jj = 0; jj < 5; ++jj) { st[jj] = (f32x16){};
#pragma unroll
                for (int ks = 0; ks < 4; ++ks) { const bf16x8 kf = *(const LAS bf16x8*)(lds + LB_K + (32 * (c + jj) + l31) * KS_STRIDE + (16 * ks + 8 * hi) * 2);
                    st[jj] = __builtin_amdgcn_mfma_f32_32x32x16_bf16(kf, qr[ks], st[jj], 0, 0, 0); } }
            const LAS float* tb = (const LAS float*)(lds + LB_TBL) + w * 192 + (31 - l31 + 4 * hi);
            float m = sink2;
#pragma unroll
            for (int jj = 0; jj < 5; ++jj) { const bool dead = (n == 0) && (c + jj < 4);
#pragma unroll
                for (int r = 0; r < 16; ++r) { float v = st[jj][r] * (0.125f * LOG2E) + tb[32 * jj + (r & 3) + 8 * (r >> 2)]; if (dead) v = -INFINITY; st[jj][r] = v; m = fmaxf(m, v); } }
            m = fmaxf(m, __shfl_xor(m, 32));
            float sum = 0.f;
#pragma unroll
            for (int jj = 0; jj < 5; ++jj)
#pragma unroll
                for (int r = 0; r < 16; ++r) { const float e = __builtin_amdgcn_exp2f(st[jj][r] - m); st[jj][r] = e; sum += e; }
            sum += __shfl_xor(sum, 32);
            const float inv = __builtin_amdgcn_rcpf(sum + __builtin_amdgcn_exp2f(sink2 - m));
            const unsigned rb = (unsigned)(row0 + 32 * c + 4 * hi);
            const unsigned colA = (unsigned)(half * 512 + w * 64 + l31);
            const unsigned offP = (rb * INW + C_GA + colA) * 2u, offY = (rb * D + colA) * 2u;
            unsigned short gav[2][16], ylv[2][16], ypv[2][16];
            asm volatile("" ::: "memory");
#pragma unroll
            for (int r = 0; r < 16; ++r) { const unsigned rk = (r & 3) + 8 * (r >> 2); gav[0][r] = LD16(P, offP + rk * (INW * 2)); ylv[0][r] = LD16(Y, offY + rk * (D * 2)); ypv[0][r] = LD16(YP, offY + rk * (D * 2)); }
            f32x16 O[2]; O[0] = (f32x16){}; O[1] = (f32x16){};
#pragma unroll
            for (int jj = 0; jj < 5; ++jj)
#pragma unroll
                for (int s2 = 0; s2 < 2; ++s2) {
                    v4u pw; pw.x = pk2(st[jj][8 * s2 + 0] * inv, st[jj][8 * s2 + 1] * inv); pw.y = pk2(st[jj][8 * s2 + 2] * inv, st[jj][8 * s2 + 3] * inv);
                    pw.z = pk2(st[jj][8 * s2 + 4] * inv, st[jj][8 * s2 + 5] * inv); pw.w = pk2(st[jj][8 * s2 + 6] * inv, st[jj][8 * s2 + 7] * inv);
                    const bf16x8 pa = __builtin_bit_cast(bf16x8, pw);
                    const int key0 = 32 * (c + jj) + 16 * s2 + 4 * hi;
#pragma unroll
                    for (int dh = 0; dh < 2; ++dh) { const LAS unsigned char* vp = lds + LB_V + (dh * 32 + l31) * VT_STRIDE + key0 * 2;
                        const u32x2 lo = *(const LAS u32x2*)vp, h2 = *(const LAS u32x2*)(vp + 16);
                        v4u vw; vw.x = lo.x; vw.y = lo.y; vw.z = h2.x; vw.w = h2.y;
                        O[dh] = __builtin_amdgcn_mfma_f32_32x32x16_bf16(pa, __builtin_bit_cast(bf16x8, vw), O[dh], 0, 0, 0); } }
            asm volatile("" ::: "memory");
#pragma unroll
            for (int r = 0; r < 16; ++r) { const unsigned rk = (r & 3) + 8 * (r >> 2); gav[1][r] = LD16(P, offP + 64u + rk * (INW * 2)); ylv[1][r] = LD16(Y, offY + 64u + rk * (D * 2)); ypv[1][r] = LD16(YP, offY + 64u + rk * (D * 2)); }
#pragma unroll
            for (int dh = 0; dh < 2; ++dh) { const float cy = dh ? cy1 : cy0;
#pragma unroll
                for (int r = 0; r < 16; ++r) { const unsigned rk = (r & 3) + 8 * (r >> 2);
                    const float y = fast_sigmoid(bf2f(gav[dh][r])) * O[dh][r] + bf2f(ylv[dh][r]) + bf2f(ypv[dh][r]) * cy;
                    *(unsigned short*)((char*)Y + (offY + 64u * dh + rk * (D * 2))) = (unsigned short)f2bf(y); } }
        }
    }
}

template <bool DRY>
__device__ __forceinline__ void phase_ln1(const Ptrs& p, int l, LAS unsigned char* lds, int gw, int NGW, int tid, int lane) {
    LAS float* rwT = (LAS float*)lds;
    for (int i = tid; i < D * NE; i += 512) rwT[(i & 15) * D + (i >> 4)] = p.router_w[i];
    __syncthreads();
    const float* xin = (l == 0) ? p.x : p.out; float* xout = DRY ? (float*)(p.ws + WS_TA) : p.out;
    const bf16* Z = (const bf16*)(p.ws + WS_H); bf16* U = DRY ? (bf16*)(p.ws + WS_TI) : (bf16*)(p.ws + WS_U);
    const float* mod_l = (const float*)(p.ws + WS_MOD) + (size_t)l * NB * 6144;
    int* eidx = (int*)(p.ws + (DRY ? WS_TZ : WS_EIDX)); float* ew = (float*)(p.ws + (DRY ? WS_TZ + MiB : WS_EW)); int* list = (int*)(p.ws + (DRY ? WS_TZ + 2 * MiB : WS_LIST));
    unsigned* cnt = (unsigned*)(p.ws + WS_CTL) + CW_CNT + l * 1024 + (DRY ? 8192 : 0);
    const float* g = p.ln1_g + l * D; const float* bt = p.ln1_b + l * D;
    LAS int* lcnt = (LAS int*)(lds + 65536); LAS int* lbase = lcnt + 16; LAS int* wrec = lcnt + 32 + (tid >> 6) * 32;
    const int nIt = (T + NGW - 1) / NGW;
    for (int it0 = 0; it0 < nIt; it0 += 8) {
    if (tid < 16) lcnt[tid] = 0;
    __syncthreads();
    f32x4 xq[4]; u32x2 zq[4];
    { const int row = gw + it0 * NGW; if (row < T) {
#pragma unroll
        for (int j = 0; j < 4; ++j) { const int col = 4 * lane + 256 * j; xq[j] = *(const f32x4*)(xin + (size_t)row * D + col); zq[j] = *(const u32x2*)(Z + (size_t)row * D + col); } } }
#pragma unroll 1
    for (int kk = 0; kk < 8; ++kk) { const int row = gw + (it0 + kk) * NGW; if (row >= T) break;
        const float* m = mod_l + (size_t)(row / SEQ) * 6144;
        f32x4 xc_[4]; u32x2 zc_[4];
#pragma unroll
        for (int j = 0; j < 4; ++j) { xc_[j] = xq[j]; zc_[j] = zq[j]; }
        { const int rown = row + NGW; if (kk + 1 < 8 && rown < T) {
#pragma unroll
            for (int j = 0; j < 4; ++j) { const int col = 4 * lane + 256 * j; xq[j] = *(const f32x4*)(xin + (size_t)rown * D + col); zq[j] = *(const u32x2*)(Z + (size_t)rown * D + col); } } }
        f32x4 v[4]; float s = 0.f;
#pragma unroll
        for (int j = 0; j < 4; ++j) { const int col = 4 * lane + 256 * j; const f32x4 xv = xc_[j], g1 = *(const f32x4*)(m + 2048 + col);
            const u32x2 zz = zc_[j];
            const f32x4 zf = (f32x4){bf2f(zz.x & 0xffffu), bf2f(zz.x >> 16), bf2f(zz.y & 0xffffu), bf2f(zz.y >> 16)};
            v[j] = xv * ALPHA + g1 * zf; s += (v[j][0] + v[j][1]) + (v[j][2] + v[j][3]); }
        const float mean = wave_sum(s) * (1.f / D); float q = 0.f;
#pragma unroll
        for (int j = 0; j < 4; ++j) { v[j] = v[j] - mean; q += (v[j][0] * v[j][0] + v[j][1] * v[j][1]) + (v[j][2] * v[j][2] + v[j][3] * v[j][3]); }
        const float rstd = 1.0f / sqrtf(wave_sum(q) * (1.f / D) + LN_EPS);
        float lg[16];
#pragma unroll
        for (int e = 0; e < 16; ++e) lg[e] = 0.f;
#pragma unroll
        for (int j = 0; j < 4; ++j) { const int col = 4 * lane + 256 * j; const f32x4 gm = *(const f32x4*)(g + col), be = *(const f32x4*)(bt + col);
            const f32x4 xn = v[j] * rstd * gm + be; *(f32x4*)(xout + (size_t)row * D + col) = xn;
            const f32x4 sc = *(const f32x4*)(m + 4096 + col), sh = *(const f32x4*)(m + 3072 + col); const f32x4 uu = xn * (sc + 1.0f) + sh;
            u32x2 o; o.x = pk2(uu[0], uu[1]); o.y = pk2(uu[2], uu[3]); *(u32x2*)(U + (size_t)row * D + col) = o;
#pragma unroll
            for (int e = 0; e < 16; ++e) { const f32x4 rw = *(const LAS f32x4*)(rwT + e * D + col); lg[e] += (uu[0] * rw[0] + uu[1] * rw[1]) + (uu[2] * rw[2] + uu[3] * rw[3]); }
            asm volatile("" ::: "memory"); }
#pragma unroll
        for (int e = 0; e < 16; ++e) lg[e] = wave_sum(lg[e]);
        float sc[16]; float mx = -INFINITY;
#pragma unroll
        for (int e = 0; e < 16; ++e) { sc[e] = lg[e] + p.router_b[e]; mx = fmaxf(mx, sc[e]); }
        float sum = 0.f;
#pragma unroll
        for (int e = 0; e < 16; ++e) { sc[e] = __expf(sc[e] - mx); sum += sc[e]; }
        const float isum = 1.0f / sum;
#pragma unroll
        for (int e = 0; e < 16; ++e) sc[e] *= isum;
        int gsel = 0, bi0 = 0, bi1 = 1; float best = -1.f, bw0 = 0.f, bw1 = 0.f;
#pragma unroll
        for (int gI = 0; gI < 4; ++gI) {
            int i0 = 0; float w0 = sc[gI * 4];
#pragma unroll
            for (int k = 1; k < 4; ++k) if (sc[gI * 4 + k] > w0) { w0 = sc[gI * 4 + k]; i0 = k; }
            int i1 = -1; float w1 = -1.f;
#pragma unroll
            for (int k = 0; k < 4; ++k) if (k != i0 && sc[gI * 4 + k] > w1) { w1 = sc[gI * 4 + k]; i1 = k; }
            const float gs = w0 + w1;
            if (gs > best) { best = gs; gsel = gI; bi0 = i0; bi1 = i1; bw0 = w0; bw1 = w1; }
        }
        if (lane == 0) {
            const float wsum = bw0 + bw1; const int e0 = gsel * 4 + bi0, e1 = gsel * 4 + bi1;
            eidx[row * 2 + 0] = e0; eidx[row * 2 + 1] = e1; ew[row * 2 + 0] = bw0 / wsum; ew[row * 2 + 1] = bw1 / wsum;
            wrec[kk * 4 + 0] = e0; wrec[kk * 4 + 1] = __hip_atomic_fetch_add(lcnt + e0, 1, __ATOMIC_RELAXED, __HIP_MEMORY_SCOPE_WORKGROUP);
            wrec[kk * 4 + 2] = e1; wrec[kk * 4 + 3] = __hip_atomic_fetch_add(lcnt + e1, 1, __ATOMIC_RELAXED, __HIP_MEMORY_SCOPE_WORKGROUP);
        }
    }
    __syncthreads();
    if (tid < 16) lbase[tid] = (int)__hip_atomic_fetch_add(cnt + 64 * tid, (unsigned)lcnt[tid], __ATOMIC_RELAXED, __HIP_MEMORY_SCOPE_AGENT);
    __syncthreads();
    if (lane < 8) { const int row = gw + (it0 + lane) * NGW;
        if (row < T) { const int e0 = wrec[lane * 4 + 0], r0 = wrec[lane * 4 + 1], e1 = wrec[lane * 4 + 2], r1 = wrec[lane * 4 + 3];
            list[e0 * 16384 + lbase[e0] + r0] = row * 2 + 0; list[e1 * 16384 + lbase[e1] + r1] = row * 2 + 1; } }
    __syncthreads();
    }
}
template <bool DRY>
__device__ __forceinline__ void phase_ln2(const Ptrs& p, int l, int gw, int NGW, int lane) {
    float* x = p.out; float* xo = DRY ? (float*)(p.ws + WS_TA) : p.out; const bf16* F0 = (const bf16*)(p.ws + WS_P); const bf16* F1 = F0 + (size_t)T * D; bf16* U = (bf16*)(p.ws + WS_U);
    const float* mod_l = (const float*)(p.ws + WS_MOD) + (size_t)l * NB * 6144; const float* mod_n = mod_l + NB * 6144;
    const float* ew = (const float*)(p.ws + WS_EW); if (DRY) U = (bf16*)(p.ws + WS_TI);
    const float* g = p.ln2_g + l * D; const float* bt = p.ln2_b + l * D;
    f32x4 xq[4]; u32x2 aq[4], cq[4]; float wq = 0.f;
    if (gw < T) { wq = ew[gw * 2 + (lane & 1)];
#pragma unroll
        for (int j = 0; j < 4; ++j) { const int col = 4 * lane + 256 * j; xq[j] = *(const f32x4*)(x + (size_t)gw * D + col); aq[j] = *(const u32x2*)(F0 + (size_t)gw * D + col); cq[j] = *(const u32x2*)(F1 + (size_t)gw * D + col); } }
#pragma unroll 1
    for (int row = gw; row < T; row += NGW) {
        const float* m = mod_l + (size_t)(row / SEQ) * 6144; const float* mn = mod_n + (size_t)(row / SEQ) * 6144;
        const float wv = wq;
        f32x4 xc_[4]; u32x2 ac_[4], cc_[4];
#pragma unroll
        for (int j = 0; j < 4; ++j) { xc_[j] = xq[j]; ac_[j] = aq[j]; cc_[j] = cq[j]; }
        { const int rown = row + NGW; if (rown < T) { wq = ew[rown * 2 + (lane & 1)];
#pragma unroll
            for (int j = 0; j < 4; ++j) { const int col = 4 * lane + 256 * j; xq[j] = *(const f32x4*)(x + (size_t)rown * D + col); aq[j] = *(const u32x2*)(F0 + (size_t)rown * D + col); cq[j] = *(const u32x2*)(F1 + (size_t)rown * D + col); } } }
        const float w0 = __int_as_float(__builtin_amdgcn_readlane(__float_as_int(wv), 0)), w1 = __int_as_float(__builtin_amdgcn_readlane(__float_as_int(wv), 1));
        f32x4 v[4]; float s = 0.f;
#pragma unroll
        for (int j = 0; j < 4; ++j) { const int col = 4 * lane + 256 * j; const f32x4 xv = xc_[j], g2 = *(const f32x4*)(m + 5120 + col);
            const u32x2 a = ac_[j], c2 = cc_[j];
            const f32x4 f = (f32x4){bf2f(a.x & 0xffffu), bf2f(a.x >> 16), bf2f(a.y & 0xffffu), bf2f(a.y >> 16)} * w0 + (f32x4){bf2f(c2.x & 0xffffu), bf2f(c2.x >> 16), bf2f(c2.y & 0xffffu), bf2f(c2.y >> 16)} * w1;
            v[j] = xv * ALPHA + g2 * f; s += (v[j][0] + v[j][1]) + (v[j][2] + v[j][3]); }
        const float mean = wave_sum(s) * (1.f / D); float q = 0.f;
#pragma unroll
        for (int j = 0; j < 4; ++j) { v[j] = v[j] - mean; q += (v[j][0] * v[j][0] + v[j][1] * v[j][1]) + (v[j][2] * v[j][2] + v[j][3] * v[j][3]); }
        const float rstd = 1.0f / sqrtf(wave_sum(q) * (1.f / D) + LN_EPS);
#pragma unroll
        for (int j = 0; j < 4; ++j) { const int col = 4 * lane + 256 * j; const f32x4 gm = *(const f32x4*)(g + col), be = *(const f32x4*)(bt + col);
            const f32x4 xn = v[j] * rstd * gm + be; *(f32x4*)(xo + (size_t)row * D + col) = xn;
            if (l + 1 < NL) { const f32x4 sh = *(const f32x4*)(mn + col), sc = *(const f32x4*)(mn + 1024 + col); const f32x4 uu = xn * (sc + 1.0f) + sh;
                u32x2 o; o.x = pk2(uu[0], uu[1]); o.y = pk2(uu[2], uu[3]); *(u32x2*)(U + (size_t)row * D + col) = o; } }
    }
}
constexpr int N_PHASES = 2 + 8 * NL;
#ifndef REP_A
#define REP_A 1
#endif
#ifndef REP_B1
#define REP_B1 1
#endif
#ifndef REP_B2
#define REP_B2 1
#endif
#ifndef REP_C
#define REP_C 1
#endif
#ifndef REP_D
#define REP_D 1
#endif
#ifndef REP_E
#define REP_E 1
#endif
#ifndef REP_C2
#define REP_C2 1
#endif
#ifndef REP_F
#define REP_F 1
#endif
#ifndef REP_CV
#define REP_CV 1
#endif
#ifndef REP_P0
#define REP_P0 1
#endif
struct Args { const float* in[24]; float* out; unsigned char* ws; int ph_lo, ph_hi; };
__global__ void __launch_bounds__(NWAVES * 64, 2) fwd(Args args) {
    extern __shared__ __attribute__((aligned(16))) unsigned char lds_raw[];
    LAS unsigned char* lds = (LAS unsigned char*)lds_raw;
    const int tid = threadIdx.x, lane = tid & 63, wave = __builtin_amdgcn_readfirstlane(tid >> 6);
    const int G = gridDim.x, bx = blockIdx.x, vcu = (G % 8 == 0) ? (bx % 8) * (G / 8) + bx / 8 : bx;
    const int gw = vcu * NWAVES + wave, NGW = G * NWAVES;
    Ptrs p;
    p.x = args.in[0]; p.c = args.in[1]; p.ada_w = args.in[2]; p.ada_b = args.in[3]; p.w_in = args.in[4]; p.attn_sink = args.in[5]; p.rel_bias = args.in[6]; p.conv_w = args.in[7]; p.conv_b = args.in[8];
    p.lru_wa = args.in[9]; p.lru_ba = args.in[10]; p.lru_wx = args.in[11]; p.lru_bx = args.in[12]; p.lru_lambda = args.in[13]; p.w_out = args.in[14]; p.ln1_g = args.in[15]; p.ln1_b = args.in[16];
    p.router_w = args.in[17]; p.router_b = args.in[18]; p.moe_wg = args.in[19]; p.moe_wu = args.in[20]; p.moe_wd = args.in[21]; p.ln2_g = args.in[22]; p.ln2_b = args.in[23];
    p.out = args.out; p.ws = args.ws;
    LAS unsigned* ctlw = (LAS unsigned*)(lds + LDSCTL_OFF);
    for (int u = tid; u < 256; u += NWAVES * 64) ctlw[u] = 0u;
    __syncthreads();
    const int lo = args.ph_lo, hi = args.ph_hi;
    XcdBarrier bar; bar.bar = (unsigned*)(p.ws + WS_CTL) + CW_BAR; bar.x = 0; bar.st = nullptr;
    if (hi - lo > 1) bar = xcd_barrier_post((unsigned*)(p.ws + WS_CTL) + CW_BAR, (volatile LAS unsigned*)(ctlw + 16));
#define IN(k) (lo <= (k) && (k) < hi)
#define LAUNDER_TID() int tidp = threadIdx.x; asm volatile("" : "+v"(tidp)); const int lanep = tidp & 63, wavep = __builtin_amdgcn_readfirstlane(tidp >> 6), gwp = vcu * NWAVES + wavep; (void)lanep; (void)gwp
#define SEAM(k) do { if (IN(k) && IN((k) + 1)) xcd_barrier(bar); } while (0)
    bf16* U = (bf16*)(p.ws + WS_U); bf16* Pb = (bf16*)(p.ws + WS_P); bf16* Yb = (bf16*)(p.ws + WS_Y); bf16* Hb = (bf16*)(p.ws + WS_H);
    const float* mod = (const float*)(p.ws + WS_MOD);

    for (int rep_ = 0; rep_ < REP_P0; ++rep_) {
        if (IN(0)) { LAUNDER_TID(); if (bx < NL * 24) mod_item(p, bx, lds, tidp, wavep, lanep); convert_layer(p, 0, lds, gwp, NGW, wavep, lanep); }
    SEAM(0); }

    if (IN(1)) { LAUNDER_TID(); modulate_rows(p.x, mod, U, gwp, NGW, lanep); }
    SEAM(1);
#pragma unroll 1
    for (int l = 0; l < NL; ++l) {
        const int pb = 2 + 8 * l;
        for (int rep_ = 0; rep_ < REP_A; ++rep_) {
        if (IN(pb + 0)) { LAUNDER_TID(); pg8::Gemm g{U, (const bf16*)(p.ws + WS_WIN), T, INW, D}; pg8::StaticOrder S; S.init(T, INW, G, bx); pg8::EpiStoreBf16 E{Pb, INW};
            pg8::gemm_phase<pg8::EpiStoreBf16, pg8::StaticOrder, true, false>(lds + RING_OFF, g, S, E, tidp); }
        SEAM(pb + 0); }

        for (int rep_ = 0; rep_ < REP_B1; ++rep_) {
        if (IN(pb + 1)) phase_lru(p, l, lds, vcu, G);
        SEAM(pb + 1); }

        for (int rep_ = 0; rep_ < REP_B2; ++rep_) {
        if (IN(pb + 2)) phase_attn(p, l, lds, vcu, G);
        SEAM(pb + 2); }

        for (int rep_ = 0; rep_ < REP_C; ++rep_) {
        if (IN(pb + 3)) { LAUNDER_TID(); pg8::Gemm g{Yb, (const bf16*)(p.ws + WS_WO), T, D, D}; pg8::StaticOrder S; S.init(T, D, G, bx); pg8::EpiStoreBf16 E{Hb, D};
            pg8::gemm_phase<pg8::EpiStoreBf16, pg8::StaticOrder, false, false>(lds + RING_OFF, g, S, E, tidp); }
        SEAM(pb + 3); }

        for (int rep_ = 1; rep_ < REP_C2; ++rep_) { if (IN(pb + 4)) { LAUNDER_TID(); phase_ln1<true>(p, l, lds, gwp, NGW, tidp, lanep); } SEAM(pb + 3); }
        if (IN(pb + 4)) { LAUNDER_TID(); phase_ln1<false>(p, l, lds, gwp, NGW, tidp, lanep); }
        SEAM(pb + 4);
        for (int rep_ = 0; rep_ < REP_D; ++rep_) {
        if (IN(pb + 5)) { LAUNDER_TID();
            if (tidp < 16) ((LAS int*)ctlw)[tidp] = (int)__hip_atomic_load((unsigned*)(p.ws + WS_CTL) + CW_CNT + l * 1024 + 64 * tidp, __ATOMIC_RELAXED, __HIP_MEMORY_SCOPE_AGENT);
            __syncthreads();
            pg8::Gemm g{U, (const bf16*)(p.ws + WS_WGU), T, NE * 1024, D}; pg8::MoeOrder S{(const LAS int*)ctlw, (const int*)(p.ws + WS_LIST), G, vcu}; pg8::EpiMoeGU E{Hb};
            pg8::gemm_phase<pg8::EpiMoeGU, pg8::MoeOrder, true, true>(lds + RING_OFF, g, S, E, tidp); }
        SEAM(pb + 5); }

        for (int rep_ = 0; rep_ < REP_E; ++rep_) {
        if (IN(pb + 6)) { LAUNDER_TID();
            if (tidp < 16) ((LAS int*)ctlw)[tidp] = (int)__hip_atomic_load((unsigned*)(p.ws + WS_CTL) + CW_CNT + l * 1024 + 64 * tidp, __ATOMIC_RELAXED, __HIP_MEMORY_SCOPE_AGENT);
            __syncthreads();
            pg8::Gemm g{Hb, (const bf16*)(p.ws + WS_WD), 36864, NE * 1024, FF}; pg8::MoeOrder S{(const LAS int*)ctlw, (const int*)(p.ws + WS_LIST), G, vcu}; pg8::EpiMoeDown E{Pb, (const int*)(p.ws + WS_LIST), T};
            pg8::gemm_phase<pg8::EpiMoeDown, pg8::MoeOrder, true, false>(lds + RING_OFF, g, S, E, tidp); }
        SEAM(pb + 6); }

        for (int rep_ = 1; rep_ < REP_F; ++rep_) { if (IN(pb + 7)) { LAUNDER_TID(); phase_ln2<true>(p, l, gwp, NGW, lanep); } SEAM(pb + 6); }
        for (int rep_ = 1; rep_ < REP_CV; ++rep_) { if (IN(pb + 7)) { LAUNDER_TID(); if (l + 1 < NL) convert_layer(p, l + 1, lds, gwp, NGW, wavep, lanep); } SEAM(pb + 6); }
        if (IN(pb + 7)) { LAUNDER_TID(); phase_ln2<false>(p, l, gwp, NGW, lanep); if (l + 1 < NL) convert_layer(p, l + 1, lds, gwp, NGW, wavep, lanep); }
        SEAM(pb + 7);
    }
#undef IN
#undef SEAM
}
#ifndef MK_SPLIT
#define MK_SPLIT 0
#endif
extern "C" void kernel_launch(void* const* d_in, const int* in_sizes, int n_in, void* d_out, int out_size, void* d_ws, size_t ws_size, hipStream_t stream) {
    static int grid = 0;
    if (grid == 0) {
        if (n_in != 24 || in_sizes[0] != T * D || out_size != T * D || ws_size < WS_END) { fprintf(stderr, "kernel_launch: unexpected shapes (n_in %d, in0 %d, out %d, ws %zu); nothing launched\n", n_in, n_in > 0 ? in_sizes[0] : -1, out_size, ws_size); grid = -1; return; }
        int dev = 0, cus = 0, per_cu = 0;
        if (hipGetDevice(&dev) != hipSuccess || hipDeviceGetAttribute(&cus, hipDeviceAttributeMultiprocessorCount, dev) != hipSuccess) { fprintf(stderr, "kernel_launch: device query failed\n"); grid = -1; return; }
        if (hipFuncSetAttribute((const void*)fwd, hipFuncAttributeMaxDynamicSharedMemorySize, LDS_BYTES) != hipSuccess) { fprintf(stderr, "kernel_launch: hipFuncSetAttribute failed\n"); grid = -1; return; }
        if (hipOccupancyMaxActiveBlocksPerMultiprocessor(&per_cu, (const void*)fwd, NWAVES * 64, LDS_BYTES) != hipSuccess || per_cu < 1) fprintf(stderr, "kernel_launch: occupancy query reports %d blocks per CU\n", per_cu);
        (void)hipGetLastError();
        grid = cus;
    }
    if (grid < 0) return;
    if (hipMemsetAsync((char*)d_ws + WS_CTL, 0, CTL_ZERO_BYTES, stream) != hipSuccess) { fprintf(stderr, "kernel_launch: memset failed\n"); return; }
    Args a{};
    for (int i = 0; i < 24; ++i) a.in[i] = (const float*)d_in[i];
    a.out = (float*)d_out; a.ws = (unsigned char*)d_ws;
#if MK_SPLIT
    for (int ph = 0; ph < N_PHASES; ++ph) { a.ph_lo = ph; a.ph_hi = ph + 1; hipLaunchKernelGGL(fwd, dim3(grid), dim3(NWAVES * 64), LDS_BYTES, stream, a); }
#else
    a.ph_lo = 0; a.ph_hi = N_PHASES; hipLaunchKernelGGL(fwd, dim3(grid), dim3(NWAVES * 64), LDS_BYTES, stream, a);
#endif
    const hipError_t le = hipPeekAtLastError();
    if (le != hipSuccess) fprintf(stderr, "kernel_launch: launch failed: %s\n", hipGetErrorName(le));
}
```

```cpp
#include <hip/hip_runtime.h>
#include <cstdio>
#include <cstdint>
#define MK_SPLIT 0
namespace pg8 {
#define PG8_LAS __attribute__((address_space(3)))
typedef unsigned short bf16_t;
typedef short bf16x8 __attribute__((ext_vector_type(8)));
typedef float f32x4 __attribute__((ext_vector_type(4)));
typedef unsigned u32x4 __attribute__((ext_vector_type(4)));
constexpr int BM = 256, BK = 64, HALF = 128, HTB = HALF * BK * 2  , STAGE_BYTES = 8 * HTB, NXCD = 8, WGM = 8;

__host__ __device__ __forceinline__ int lds_byte(int r, int c) { const int st = (r >> 4) * 2 + (c >> 5), rr = r & 15, cc = c & 31, ob = rr * 64 + cc * 2; return st * 1024 + (ob ^ (((ob >> 9) & 1) << 5)); }
__host__ __device__ __forceinline__ void stage_rc(int b, int& R, int& C) { const int st = b / 1024, sb = b % 1024, swz = sb ^ (((sb >> 9) & 1) << 5); R = (st >> 1) * 16 + swz / 64; C = (st & 1) * 32 + (swz % 64) / 2; }
__host__ __device__ __forceinline__ int perm32(int rho) { const int n = rho >> 4, i = rho & 15; return 8 * (i >> 2) + 4 * n + (i & 3); }

struct Unit { int pm, pn, e, mt, nv; };
struct Gemm { const bf16_t* A; const bf16_t* Bt; int M, N, K; };

struct StaticOrder {
    int nM, nN, nwg, G, c;
    __host__ __device__ void init(int M, int N, int G_, int c_) { nM = M / BM; nN = N / BM; nwg = nM * nN; G = G_; c = c_; }
    __host__ __device__ bool next(int i, Unit& u) const {
        const long L = (long)i * G + c; if (L >= nwg) return false;
        int wgid = (int)L; { const int q = nwg / NXCD, r = nwg % NXCD, xcd = wgid % NXCD, off = wgid / NXCD; wgid = (xcd < r ? xcd * (q + 1) : r * (q + 1) + (xcd - r) * q) + off; }
        const int nig = WGM * nN, gid = wgid / nig, fm = gid * WGM, gsz = (nM - fm) < WGM ? (nM - fm) : WGM;
        u.pm = fm + ((wgid % nig) % gsz); u.pn = (wgid % nig) / gsz; u.e = 0; u.mt = 0; u.nv = 256; return true;
    }
    __device__ __forceinline__ void a_ready(const Unit&) const {}
    __device__ __forceinline__ void done(const Unit&) const {}
};

__device__ __forceinline__ unsigned cvt_pk_bf16(float lo, float hi) { unsigned r; asm volatile("v_cvt_pk_bf16_f32 %0, %1, %2" : "=v"(r) : "v"(lo), "v"(hi)); return r; }
typedef float f32x2 __attribute__((ext_vector_type(2)));
__device__ __forceinline__ f32x2 gelu_pk(f32x2 v) {
    const f32x2 av = __builtin_elementwise_abs(v), d = av * 0.2316418882f + 1.0f;
    f32x2 t; t.x = __builtin_amdgcn_rcpf(d.x); t.y = __builtin_amdgcn_rcpf(d.y);
    f32x2 q = t * 0.5307027145f + (-0.7265760135f); q = q * t + 0.7107068705f; q = q * t + (-0.142248368f); q = q * t + 0.127414796f; q = q * t;
    const f32x2 s = (v * v) * (-0.72134752044f);
    f32x2 e; e.x = __builtin_amdgcn_exp2f(s.x); e.y = __builtin_amdgcn_exp2f(s.y);
    const f32x2 m = v * (q * e), r = v - m;
    f32x2 o; o.x = v.x < 0.f ? m.x : r.x; o.y = v.y < 0.f ? m.y : r.y; return o;
}

struct EpiStoreBf16 {
    static constexpr bool PERM = true, AFTER_DRAIN = false;
    bf16_t* O; int ldc;
    __device__ __forceinline__ void operator()(const f32x4 (&acc)[2][2][4][2], const Unit& u, int wr, int wc, int fr, int fq) const {
        const int row0 = u.pm * BM + wr * 64 + fr, col0 = u.pn * BM + wc * 32 + 8 * fq;
#pragma unroll
        for (int ai = 0; ai < 2; ++ai)
#pragma unroll
            for (int m = 0; m < 4; ++m) { bf16_t* rowp = O + (size_t)(row0 + ai * HALF + m * 16) * ldc + col0;
#pragma unroll
                for (int bj = 0; bj < 2; ++bj) { const f32x4 v0 = acc[ai][bj][m][0], v1 = acc[ai][bj][m][1];
                    u32x4 w; w.x = cvt_pk_bf16(v0[0], v0[1]); w.y = cvt_pk_bf16(v0[2], v0[3]); w.z = cvt_pk_bf16(v1[0], v1[1]); w.w = cvt_pk_bf16(v1[2], v1[3]);
                    *(u32x4*)(rowp + bj * HALF) = w; } }
    }
};
__device__ __forceinline__ float silu_f(float x) { return x * __builtin_amdgcn_rcpf(1.0f + __builtin_amdgcn_exp2f(-1.4426950408889634f * x)); }
struct EpiMoeGU {
    static constexpr bool PERM = true, AFTER_DRAIN = false;
    bf16_t* H;
    __device__ __forceinline__ void operator()(const f32x4 (&acc)[2][2][4][2], const Unit& u, int wr, int wc, int fr, int fq) const {
        const int row0 = u.pm * BM + wr * 64 + fr, hc0 = (u.pn & 3) * 128 + wc * 32 + 8 * fq;
#pragma unroll
        for (int ai = 0; ai < 2; ++ai)
#pragma unroll
            for (int m = 0; m < 4; ++m) { bf16_t* rowp = H + (size_t)(row0 + ai * HALF + m * 16) * 512 + hc0;
                const f32x4 g0 = acc[ai][0][m][0], g1 = acc[ai][0][m][1], u0 = acc[ai][1][m][0], u1 = acc[ai][1][m][1];
                u32x4 w; w.x = cvt_pk_bf16(silu_f(g0[0]) * u0[0], silu_f(g0[1]) * u0[1]); w.y = cvt_pk_bf16(silu_f(g0[2]) * u0[2], silu_f(g0[3]) * u0[3]);
                w.z = cvt_pk_bf16(silu_f(g1[0]) * u1[0], silu_f(g1[1]) * u1[1]); w.w = cvt_pk_bf16(silu_f(g1[2]) * u1[2], silu_f(g1[3]) * u1[3]);
                *(u32x4*)rowp = w; }
    }
};
struct EpiMoeDown {
    static constexpr bool PERM = true, AFTER_DRAIN = false;
    bf16_t* F; const int* list; int T;
    __device__ __forceinline__ void operator()(const f32x4 (&acc)[2][2][4][2], const Unit& u, int wr, int wc, int fr, int fq) const {
        const int* lb = list + u.e * 16384 + u.mt * BM; const int col0 = (u.pn & 3) * BM + wc * 32 + 8 * fq;
#pragma unroll
        for (int ai = 0; ai < 2; ++ai)
#pragma unroll
            for (int m = 0; m < 4; ++m) { const int rl = ai * HALF + wr * 64 + m * 16 + fr;
                if (rl < u.nv) { const int ent = lb[rl]; bf16_t* rowp = F + ((size_t)(ent & 1) * T + (ent >> 1)) * 1024 + col0;
#pragma unroll
                    for (int bj = 0; bj < 2; ++bj) { const f32x4 v0 = acc[ai][bj][m][0], v1 = acc[ai][bj][m][1];
                        u32x4 w; w.x = cvt_pk_bf16(v0[0], v0[1]); w.y = cvt_pk_bf16(v0[2], v0[3]); w.z = cvt_pk_bf16(v1[0], v1[1]); w.w = cvt_pk_bf16(v1[2], v1[3]);
                        *(u32x4*)(rowp + bj * HALF) = w; } } }
    }
};
struct MoeOrder {
    const PG8_LAS int* cntl; const int* list; int G, c;
    __device__ __forceinline__ bool next(int i, Unit& u) const {
        const int L = i * G + c, tile = L >> 2; int acc = 0;
#pragma unroll 1
        for (int e = 0; e < 16; ++e) { const int ce = cntl[e], nte = (ce + BM - 1) >> 8;
            if (tile < acc + nte) { u.e = e; u.mt = tile - acc; u.pm = tile; u.pn = e * 4 + (L & 3); const int rem = ce - u.mt * BM; u.nv = rem < BM ? rem : BM; return true; }
            acc += nte; }
        return false;
    }
    __device__ __forceinline__ int gather_row(const Unit& u, int r) const { const int* lb = list + u.e * 16384 + u.mt * BM; return lb[r < u.nv ? r : 0] >> 1; }
    __device__ __forceinline__ void a_ready(const Unit&) const {}
    __device__ __forceinline__ void done(const Unit&) const {}
};

template <class Epi, class Sched, bool ALIGN_EPI, bool GATHER>
__device__ __forceinline__ void gemm_phase(PG8_LAS unsigned char* lds, const Gemm g, const Sched& S, const Epi& E, const int tid) {
    const int wid = __builtin_amdgcn_readfirstlane(tid >> 6), lane = tid & 63, wr = wid >> 2, wc = wid & 3, fr = lane & 15, fq = lane >> 4;
    const int K = g.K, nt = K / BK;
    unsigned voffB[2], vC[2][2], vN[2][2]; int stR[2], stC[2];
#pragma unroll
    for (int i = 0; i < 2; ++i) { int R, C; stage_rc(tid * 16 + i * 8192, R, C); stR[i] = R; stC[i] = C; const int Rb = Epi::PERM ? ((R & ~31) + perm32(R & 31)) : R;
        voffB[i] = (unsigned)(Rb * K + C) * 2u; }
    const size_t kstep = (size_t)(BK * 2);
    const size_t hstep = (size_t)HALF * K * 2;
    const size_t tstep = 2 * hstep;
    const unsigned ldsw = (unsigned)wid * 1024u;
    const int aoff = lds_byte(wr * 64 + fr, fq * 8), boff = lds_byte(wc * 32 + fr, fq * 8);
#define PG8_SA(b, h) (((b) * 2 + (h)) * HTB)
#define PG8_SB(b, h) ((4 + (b) * 2 + (h)) * HTB)
#define PG8_STAGE(bufoff, gbase, voff) do { _Pragma("unroll") for (int _i = 0; _i < 2; ++_i) \
        __builtin_amdgcn_global_load_lds((const unsigned*)((const char*)(gbase) + (voff)[_i]), (PG8_LAS unsigned*)(lds + (bufoff) + ldsw + _i * 8192), 16, 0, 0); } while (0)
#define PG8_LDA(dst, b, h) do { _Pragma("unroll") for (int m = 0; m < 4; ++m) _Pragma("unroll") for (int k = 0; k < 2; ++k) dst[m][k] = *(const PG8_LAS bf16x8*)(lds + PG8_SA(b, h) + aoff + m * 2048 + k * 1024); } while (0)
#define PG8_LDB(dst, b, h) do { _Pragma("unroll") for (int n = 0; n < 2; ++n) _Pragma("unroll") for (int k = 0; k < 2; ++k) dst[n][k] = *(const PG8_LAS bf16x8*)(lds + PG8_SB(b, h) + boff + n * 2048 + k * 1024); } while (0)
#define PG8_MMA(ai, bj, At, Bt) do { __builtin_amdgcn_s_setprio(1); _Pragma("unroll") for (int m = 0; m < 4; ++m) _Pragma("unroll") for (int n = 0; n < 2; ++n) _Pragma("unroll") for (int k = 0; k < 2; ++k) \
        acc[ai][bj][m][n] = __builtin_amdgcn_mfma_f32_16x16x32_bf16(Bt[n][k], At[m][k], acc[ai][bj][m][n], 0, 0, 0); __builtin_amdgcn_s_setprio(0); } while (0)
#define PG8_WAIT_V(n) asm volatile("s_waitcnt vmcnt(" #n ")" ::: "memory")
#define PG8_WAIT_L(n) asm volatile("s_waitcnt lgkmcnt(" #n ")" ::: "memory")
#define PG8_BAR __builtin_amdgcn_s_barrier()
#define PG8_SCHED __builtin_amdgcn_sched_barrier(0)
#define PG8_SETV(v, u) do { _Pragma("unroll") for (int _h = 0; _h < 2; ++_h) _Pragma("unroll") for (int _i = 0; _i < 2; ++_i) { \
        if constexpr (GATHER) { const int _tok = S.gather_row(u, _h * HALF + stR[_i]); v[_h][_i] = (unsigned)(_tok * K + stC[_i]) * 2u; } \
        else v[_h][_i] = (unsigned)((_h * HALF + stR[_i]) * K + stC[_i]) * 2u; } } while (0)
#define PG8_STAGE_SEL(bufoff, gbase, h) do { _Pragma("unroll") for (int _i = 0; _i < 2; ++_i) { const unsigned _o = (GATHER && last) ? vN[h][_i] : vC[h][_i]; \
        __builtin_amdgcn_global_load_lds((const unsigned*)((const char*)(gbase) + _o), (PG8_LAS unsigned*)(lds + (bufoff) + ldsw + _i * 8192), 16, 0, 0); } } while (0)
    Unit cur, nxt; int ui = 0;
    if (!S.next(0, cur)) return;
    f32x4 acc[2][2][4][2];
#pragma unroll
    for (int a = 0; a < 2; ++a)
#pragma unroll
        for (int b = 0; b < 2; ++b)
#pragma unroll
            for (int m = 0; m < 4; ++m)
#pragma unroll
                for (int n = 0; n < 2; ++n) acc[a][b][m][n] = (f32x4){0.f, 0.f, 0.f, 0.f};
    bf16x8 At[4][2], B0[2][2], B1[2][2];
    PG8_SETV(vC, cur);
    if constexpr (GATHER) asm volatile("s_waitcnt vmcnt(0)" : "+v"(vC[0][0]), "+v"(vC[0][1]), "+v"(vC[1][0]), "+v"(vC[1][1]) :: "memory");
    const char* cA = GATHER ? (const char*)g.A : (const char*)g.A + (size_t)cur.pm * tstep; const char* cB = (const char*)g.Bt + (size_t)cur.pn * tstep;
    S.a_ready(cur);
    PG8_STAGE(PG8_SB(0, 0), cB, voffB); PG8_STAGE(PG8_SB(0, 1), cB + hstep, voffB); PG8_STAGE(PG8_SA(0, 0), cA, vC[0]); PG8_STAGE(PG8_SA(0, 1), cA, vC[1]);
    if (wr == 1) PG8_BAR;
    PG8_WAIT_V(2); PG8_BAR;
    PG8_STAGE(PG8_SB(1, 0), cB + kstep, voffB); PG8_STAGE(PG8_SA(1, 0), cA + kstep, vC[0]); PG8_STAGE(PG8_SB(1, 1), cB + hstep + kstep, voffB);
    PG8_WAIT_V(6); PG8_BAR;
    for (;;) {
        const bool has_next = S.next(ui + 1, nxt);
        if constexpr (GATHER) {
            if (has_next) { PG8_SETV(vN, nxt); asm volatile("s_waitcnt vmcnt(0)" : "+v"(vN[0][0]), "+v"(vN[0][1]), "+v"(vN[1][0]), "+v"(vN[1][1]) :: "memory"); }
            else {
#pragma unroll
                for (int h = 0; h < 2; ++h)
#pragma unroll
                    for (int i = 0; i < 2; ++i) vN[h][i] = vC[h][i]; }
        }
        const char* nA = GATHER ? cA : (has_next ? (const char*)g.A + (size_t)nxt.pm * tstep : cA); const char* nB = has_next ? (const char*)g.Bt + (size_t)nxt.pn * tstep : cB;
        for (int t = 0; t < nt; t += 2) {
            const bool last = (t == nt - 2);
            const char* a1 = cA + (size_t)(t + 1) * kstep;
            const char* a2 = last ? nA : cA + (size_t)(t + 2) * kstep; const char* b2 = last ? nB : cB + (size_t)(t + 2) * kstep;
            const char* a3 = a2 + kstep; const char* b3 = b2 + kstep;
            if (last && has_next) S.a_ready(nxt);
            PG8_LDB(B0, 0, 0); PG8_LDB(B1, 0, 1); PG8_SCHED; PG8_LDA(At, 0, 0); PG8_STAGE(PG8_SA(1, 1), a1, vC[1]);
            PG8_WAIT_V(8); PG8_WAIT_L(0); PG8_BAR; PG8_MMA(0, 0, At, B0); PG8_MMA(0, 1, At, B1); PG8_BAR; PG8_SCHED;
            PG8_LDA(At, 0, 1); PG8_STAGE(PG8_SB(0, 0), b2, voffB); PG8_STAGE(PG8_SB(0, 1), b2 + hstep, voffB); PG8_STAGE_SEL(PG8_SA(0, 0), a2, 0);
            PG8_WAIT_V(8); PG8_WAIT_L(0); PG8_BAR; PG8_MMA(1, 0, At, B0); PG8_MMA(1, 1, At, B1); PG8_BAR; PG8_SCHED;
            PG8_LDB(B0, 1, 0); PG8_LDB(B1, 1, 1); PG8_SCHED; PG8_LDA(At, 1, 0); PG8_STAGE_SEL(PG8_SA(0, 1), a2, 1);
            PG8_WAIT_V(8); PG8_WAIT_L(0); PG8_BAR; PG8_MMA(0, 0, At, B0); PG8_MMA(0, 1, At, B1); PG8_BAR; PG8_SCHED;
            PG8_LDA(At, 1, 1); PG8_STAGE(PG8_SB(1, 0), b3, voffB); PG8_STAGE(PG8_SB(1, 1), b3 + hstep, voffB); PG8_STAGE_SEL(PG8_SA(1, 0), a3, 0);
            PG8_WAIT_V(8); PG8_WAIT_L(0); PG8_BAR; PG8_MMA(1, 0, At, B0); PG8_MMA(1, 1, At, B1); PG8_BAR; PG8_SCHED;
        }
        if constexpr (ALIGN_EPI) { if (wr == 0) PG8_BAR; }
        E(acc, cur, wr, wc, fr, fq); S.done(cur);
        if (!has_next) break;
#pragma unroll
        for (int a = 0; a < 2; ++a)
#pragma unroll
            for (int b = 0; b < 2; ++b)
#pragma unroll
                for (int m = 0; m < 4; ++m)
#pragma unroll
                    for (int n = 0; n < 2; ++n) acc[a][b][m][n] = (f32x4){0.f, 0.f, 0.f, 0.f};
        cur = nxt; cA = nA; cB = nB; ++ui;
        if constexpr (GATHER) {
#pragma unroll
            for (int h = 0; h < 2; ++h)
#pragma unroll
                for (int i = 0; i < 2; ++i) vC[h][i] = vN[h][i]; }
        if constexpr (ALIGN_EPI) { if (wr == 1) PG8_BAR; }
    }
    PG8_WAIT_V(0);
    if constexpr (!ALIGN_EPI) { if (wr == 0) PG8_BAR; }
    PG8_BAR;
#undef PG8_SA
#undef PG8_SB
#undef PG8_STAGE
#undef PG8_LDA
#undef PG8_LDB
#undef PG8_MMA
#undef PG8_WAIT_V
#undef PG8_WAIT_L
#undef PG8_BAR
#undef PG8_SCHED
#undef PG8_SETV
#undef PG8_STAGE_SEL
}
}
#define GAS __attribute__((address_space(1)))
#define LAS __attribute__((address_space(3)))
typedef unsigned short bf16;
typedef unsigned v4u __attribute__((ext_vector_type(4)));
typedef float f32x4 __attribute__((ext_vector_type(4)));
typedef short bf16x8 __attribute__((ext_vector_type(8)));
typedef GAS unsigned gu32;
typedef GAS unsigned long long gu64;
#define RLX_AGENT __ATOMIC_RELAXED, __HIP_MEMORY_SCOPE_AGENT
#define LDS_WAIT() asm volatile("s_waitcnt lgkmcnt(0)" ::: "memory")
#define VM_WAIT() asm volatile("s_waitcnt vmcnt(0)" ::: "memory")
__device__ __forceinline__ unsigned long long rt() { return __builtin_amdgcn_s_memrealtime(); }
__device__ __forceinline__ unsigned pk2(float lo, float hi) { unsigned r; asm("v_cvt_pk_bf16_f32 %0, %1, %2" : "=v"(r) : "v"(lo), "v"(hi)); return r; }
__device__ __forceinline__ unsigned f2bf(float f) { return pk2(f, f) & 0xffffu; }

#define XB_TMO      128
#define XB_XCNT(j)  (256  + 64 * (j))
#define XB_XSUB(j)  (1280 + 64 * (j))
#define XB_XGEN(j)  (2304 + 64 * (j))
#define XB_TOP      3328
#define XB_TOPGEN   3392
#define XCD_BAR_WORDS 3456
#define XB_SPIN_CAP (1u << 18)

__device__ __forceinline__ unsigned xb_ld(unsigned* p)              { return __hip_atomic_load(p, __ATOMIC_RELAXED, __HIP_MEMORY_SCOPE_AGENT); }
__device__ __forceinline__ unsigned xb_add(unsigned* p, unsigned v) { return __hip_atomic_fetch_add(p, v, __ATOMIC_RELAXED, __HIP_MEMORY_SCOPE_AGENT); }
__device__ __forceinline__ unsigned xb_xcc_id() { return (unsigned)__builtin_amdgcn_s_getreg((3 << 11) | 20) & 0xFu; }
#define XB_SPIN(cond, bar) do { unsigned _sp = 0; while (cond) { __builtin_amdgcn_s_sleep(1); \
    if ((++_sp & 255u) == 0u) { if (xb_ld(&(bar)[XB_TMO])) break; if (_sp > XB_SPIN_CAP) { atomicAdd(&(bar)[XB_TMO], 1u); break; } } } } while (0)

struct XcdBarrier {
    unsigned* bar; unsigned x;
    volatile LAS unsigned* st;
};

__device__ __forceinline__ XcdBarrier xcd_barrier_post(unsigned* bar, volatile LAS unsigned* st) {
    XcdBarrier b; b.bar = bar; b.x = xb_xcc_id(); b.st = st;
    if (threadIdx.x == 0) (void)xb_add(&bar[XB_XCNT(b.x)], 1u);
    return b;
}
__device__ __forceinline__ void xcd_barrier_complete(unsigned* bar, unsigned x, unsigned& nloc, unsigned& nx) {
    const unsigned G = gridDim.x * gridDim.y * gridDim.z;
    unsigned sum, cnt, mine, sp = 0u;
    for (;;) {
        sum = 0u; cnt = 0u; mine = 0u;
#pragma unroll
        for (unsigned j = 0; j < 16; ++j) { const unsigned c = xb_ld(&bar[XB_XCNT(j)]); sum += c; cnt += (c > 0u) ? 1u : 0u; mine = (j == x) ? c : mine; }
        if (sum == G) break;
        __builtin_amdgcn_s_sleep(1);
        if ((++sp & 255u) == 0u) { if (xb_ld(&bar[XB_TMO])) break; if (sp > XB_SPIN_CAP) { atomicAdd(&bar[XB_TMO], 1u); break; } }
    }
    nloc = mine > 0u ? mine : 1u; nx = cnt > 0u ? cnt : 1u;
}

__device__ __forceinline__ void xcd_barrier(const XcdBarrier& b) {
    asm volatile("s_waitcnt vmcnt(0)" ::: "memory");
    __syncthreads();
    if (threadIdx.x == 0) {
        unsigned* bar = b.bar;
        __builtin_amdgcn_s_waitcnt(0);
        unsigned nloc = b.st[0], nx = b.st[1];
        if (nloc == 0u) { xcd_barrier_complete(bar, b.x, nloc, nx); b.st[0] = nloc; b.st[1] = nx; }
        const unsigned old = xb_add(&bar[XB_XSUB(b.x)], 1u);
        const unsigned gen = old / nloc;
        if (old + 1u == (gen + 1u) * nloc) {
            __builtin_amdgcn_fence(__ATOMIC_RELEASE, "agent");
            asm volatile("s_waitcnt vmcnt(0)" ::: "memory");
            const unsigned og = xb_add(&bar[XB_TOP], 1u);
            const unsigned tg = og / nx;
            if (og + 1u == (tg + 1u) * nx) xb_add(&bar[XB_TOPGEN], 1u);
            else XB_SPIN(xb_ld(&bar[XB_TOPGEN]) == tg, bar);
            __builtin_amdgcn_fence(__ATOMIC_ACQUIRE, "agent");
            xb_add(&bar[XB_XGEN(b.x)], 1u);
            asm volatile("s_waitcnt vmcnt(0)" ::: "memory");
        } else {
            XB_SPIN(xb_ld(&bar[XB_XGEN(b.x)]) == gen, bar);
            __builtin_amdgcn_fence(__ATOMIC_ACQUIRE, "agent");
            asm volatile("s_waitcnt vmcnt(0)" ::: "memory");
        }
    }
    __syncthreads();
}

constexpr int T = 16384, D = 1024, SEQ = 4096, NB = 4, INW = 5376, NL = 4;
constexpr int C_Q = 0, C_K = 1024, C_V = 1152, C_LX = 1280, C_LGB = 2304, C_GA = 4352;
__device__ __forceinline__ int inproj_row(int n) { return n < 2304 ? n : (n < 3328 ? 2304 + 2 * (n - 2304) : (n < 4352 ? 4352 + (n - 3328) : 2304 + 2 * (n - 4352) + 1)); }
constexpr int NE = 16, FF = 512;
constexpr float ALPHA = 1.681792830507429f;
constexpr float LN_EPS = 1e-5f;
constexpr float LOG2E = 1.4426950408889634f;
constexpr size_t MiB = 1u << 20;
constexpr size_t WS_CTL = 0, CTL_ZERO_BYTES = 1 * MiB;
constexpr int CW_TMO = 0, CW_BAR = 4096, CW_CNT = 16384;
constexpr size_t WS_MOD = 1 * MiB;
constexpr size_t WS_SUM = 2 * MiB;
constexpr size_t WS_EIDX = 3 * MiB;
constexpr size_t WS_EW = 3 * MiB + 512 * 1024;
constexpr size_t WS_LIST = 4 * MiB;
constexpr size_t WS_LRUW = 5 * MiB;
constexpr size_t WS_WIN = 6 * MiB;
constexpr size_t WS_WO = 17 * MiB;
constexpr size_t WS_WGU = 19 * MiB;
constexpr size_t WS_WD = 51 * MiB;
constexpr size_t WS_U = 68 * MiB;
constexpr size_t WS_P = 100 * MiB;
constexpr size_t WS_Y = 268 * MiB;
constexpr size_t WS_H = 300 * MiB;
constexpr size_t WS_YLP = 336 * MiB;
constexpr size_t WS_END = 400 * MiB;
constexpr size_t WS_TA = 400 * MiB, WS_TI = 464 * MiB, WS_TZ = 528 * MiB, WS_END_HYB = 592 * MiB;

constexpr int NWAVES = 8;
constexpr int RING_OFF = 0, RING_BYTES = 131072;
constexpr int LDSCTL_OFF = 147456 - 1024;
constexpr int LDS_BYTES = 147456;

typedef float f32x16 __attribute__((ext_vector_type(16)));
typedef unsigned u32x2 __attribute__((ext_vector_type(2)));
typedef float f32x2 __attribute__((ext_vector_type(2)));
__device__ __forceinline__ f32x2 ex2_2(f32x2 v) { f32x2 r; r.x = __builtin_amdgcn_exp2f(v.x); r.y = __builtin_amdgcn_exp2f(v.y); return r; }
__device__ __forceinline__ f32x2 rcp_2(f32x2 v) { f32x2 r; r.x = __builtin_amdgcn_rcpf(v.x); r.y = __builtin_amdgcn_rcpf(v.y); return r; }
__device__ __forceinline__ f32x2 sqrt_2(f32x2 v) { f32x2 r; r.x = __builtin_sqrtf(v.x); r.y = __builtin_sqrtf(v.y); return r; }
#define LD16(base, off) (*(const unsigned short*)((const char*)(base) + (off)))
__device__ __forceinline__ float bf2f(unsigned v) { return __uint_as_float(v << 16); }
__device__ __forceinline__ float fast_sigmoid(float x) { return __builtin_amdgcn_rcpf(1.0f + __builtin_amdgcn_exp2f(-LOG2E * x)); }
__device__ __forceinline__ float gelu_tanh_f(float x) { const float u = 0.7978845608028654f * (x + 0.044715f * x * x * x); return x * fast_sigmoid(2.0f * u); }
template <int CTRL, int ROW_MASK>
__device__ __forceinline__ float dpp_add(float v) {
    return v + __int_as_float(__builtin_amdgcn_update_dpp(0, __float_as_int(v), CTRL, ROW_MASK, 0xF, false)); }
__device__ __forceinline__ float wave_sum(float v) {
    v = dpp_add<0xB1, 0xF>(v);
    v = dpp_add<0x4E, 0xF>(v);
    v = dpp_add<0x141, 0xF>(v);
    v = dpp_add<0x140, 0xF>(v);
    v = dpp_add<0x142, 0xA>(v);
    v = dpp_add<0x143, 0xC>(v);
    return __int_as_float(__builtin_amdgcn_readlane(__float_as_int(v), 63));
}
__constant__ int c_bucket[128] = {0, 1, 2, 3, 4, 5, 6, 7, 8, 9, 10, 11, 12, 13, 14, 15, 16, 16, 16, 17, 17, 18, 18, 18, 19, 19, 19, 20, 20, 20, 20, 21, 21, 21, 21, 22, 22, 22, 22, 22, 23, 23, 23, 23, 23, 23, 24, 24, 24, 24, 24, 24, 25, 25, 25, 25, 25, 25, 25, 26, 26, 26, 26, 26, 26, 26, 26, 27, 27, 27, 27, 27, 27, 27, 27, 27, 27, 28, 28, 28, 28, 28, 28, 28, 28, 28, 28, 29, 29, 29, 29, 29, 29, 29, 29, 29, 29, 29, 29, 30, 30, 30, 30, 30, 30, 30, 30, 30, 30, 30, 30, 30, 30, 31, 31, 31, 31, 31, 31, 31, 31, 31, 31, 31, 31, 31, 31, 31};

struct Ptrs {
    const float *x, *c, *ada_w, *ada_b, *w_in, *attn_sink, *rel_bias, *conv_w, *conv_b, *lru_wa, *lru_ba, *lru_wx, *lru_bx, *lru_lambda, *w_out, *ln1_g, *ln1_b, *router_w, *router_b, *moe_wg, *moe_wu, *moe_wd, *ln2_g, *ln2_b;
    float* out; unsigned char* ws;
};

template <bool INMAP = false>
__device__ __forceinline__ void transpose_item(const float* W, int K, int N, bf16* WT, int row_off, int item, int lane) {
    const int nblk = N / 32, kbi = item / nblk, nb = item % nblk, k0 = 64 * kbi + 8 * (lane >> 3), n0 = 32 * nb + 4 * (lane & 7);
    f32x4 v[8];
#pragma unroll
    for (int i = 0; i < 8; ++i) v[i] = *(const f32x4*)(W + (size_t)(k0 + i) * N + n0);
#pragma unroll
    for (int j = 0; j < 4; ++j) { v4u o; o.x = pk2(v[0][j], v[1][j]); o.y = pk2(v[2][j], v[3][j]); o.z = pk2(v[4][j], v[5][j]); o.w = pk2(v[6][j], v[7][j]);
        *(GAS v4u*)(WT + (size_t)(INMAP ? inproj_row(n0 + j) : row_off + n0 + j) * K + k0) = o; }
}
__device__ __forceinline__ void convert_layer(const Ptrs& p, int l, LAS unsigned char* lds, int gw, int NGW, int wave, int lane) {
    (void)lds; (void)wave;
    constexpr int I_IN = (D / 64) * (INW / 32), I_O = (D / 64) * (D / 32), I_GU = 2 * NE * 256, I_D = NE * 256, I_L = 128;
    constexpr int NITEMS = I_IN + I_O + I_GU + I_D + I_L;
    bf16* WinT = (bf16*)(p.ws + WS_WIN); bf16* WoT = (bf16*)(p.ws + WS_WO); bf16* WguT = (bf16*)(p.ws + WS_WGU); bf16* WdT = (bf16*)(p.ws + WS_WD); bf16* waT = (bf16*)(p.ws + WS_LRUW); bf16* wxT = waT + 8 * 128 * 128;
    for (int it = gw; it < NITEMS; it += NGW) {
        int r = it;
        if (r < I_IN) { transpose_item<true>(p.w_in + (size_t)l * D * INW, D, INW, WinT, 0, r, lane); continue; } r -= I_IN;
        if (r < I_O) { transpose_item(p.w_out + (size_t)l * D * D, D, D, WoT, 0, r, lane); continue; } r -= I_O;
        if (r < I_GU) { const int mat = r / (NE * 256); const int q = r % (NE * 256); const int e = q / 256, ti = q % 256; const int n0 = 32 * (ti % 16);
            const float* W = (mat ? p.moe_wu : p.moe_wg) + ((size_t)l * NE + e) * D * FF;
            transpose_item(W, D, FF, WguT, e * 1024 + (n0 / 128) * 256 + mat * 128 + (n0 % 128) - n0, ti, lane); continue; } r -= I_GU;
        if (r < I_D) { const int e = r / 256, ti = r % 256; transpose_item(p.moe_wd + ((size_t)l * NE + e) * FF * D, FF, D, WdT, e * 1024, ti, lane); continue; } r -= I_D;
        { const int mat = r / 64; const int q = r % 64; const int hb = q / 8, ti = q % 8;
            transpose_item((mat ? p.lru_wx : p.lru_wa) + ((size_t)l * 8 + hb) * 128 * 128, 128, 128, mat ? wxT : waT, hb * 128, ti, lane); }
    }
}
__device__ __forceinline__ void mod_item(const Ptrs& p, int item, LAS unsigned char* lds, int tid, int wave, int lane) {
    LAS float* ca = (LAS float*)lds;
    LAS float* red = (LAS float*)(lds + 16384);
    const int l = item / 24, j0 = (item % 24) * 256;
    for (int i = tid; i < NB * D; i += 512) { const float v = p.c[i]; ca[i] = v * fast_sigmoid(v); }
    __syncthreads();
    f32x4 acc[NB];
#pragma unroll
    for (int b = 0; b < NB; ++b) acc[b] = (f32x4){0.f, 0.f, 0.f, 0.f};
    const float* w = p.ada_w + (size_t)l * D * 6144 + j0 + 4 * lane;
#pragma unroll 8
    for (int kk = 0; kk < 128; ++kk) { const int k = wave * 128 + kk; const f32x4 wv = *(const f32x4*)(w + (size_t)k * 6144);
#pragma unroll
        for (int b = 0; b < NB; ++b) acc[b] += wv * ca[b * D + k]; }
#pragma unroll
    for (int b = 0; b < NB; ++b) *(LAS f32x4*)(red + (wave * NB + b) * 256 + 4 * lane) = acc[b];
    __syncthreads();
    float* mod = (float*)(p.ws + WS_MOD);
    for (int i = tid; i < NB * 256; i += 512) { const int b = i / 256, jj = i % 256; float s = 0.f;
#pragma unroll
        for (int w8 = 0; w8 < 8; ++w8) s += red[(w8 * NB + b) * 256 + jj];
        mod[((size_t)l * NB + b) * 6144 + j0 + jj] = s + p.ada_b[l * 6144 + j0 + jj]; }
    __syncthreads();
}
__device__ __forceinline__ void modulate_rows(const float* x, const float* mod_l, bf16* U, int gw, int NGW, int lane) {
    for (int row = gw; row < T; row += NGW) { const float* m = mod_l + (size_t)(row / SEQ) * 6144;
#pragma unroll
        for (int j = 0; j < 4; ++j) { const int col = 4 * lane + 256 * j; const f32x4 xv = *(const f32x4*)(x + (size_t)row * D + col), sh = *(const f32x4*)(m + col), sc = *(const f32x4*)(m + 1024 + col);
            const f32x4 u = xv * (sc + 1.0f) + sh; u32x2 o; o.x = pk2(u[0], u[1]); o.y = pk2(u[2], u[3]); *(u32x2*)(U + (size_t)row * D + col) = o; } }
}

constexpr int XC_STRIDE = 272;
constexpr int LX_XC = 0, LX_END = 4 * 128 * XC_STRIDE;
__device__ __forceinline__ void phase_lru(const Ptrs& p, int l, LAS unsigned char* lds, int vcu, int G) {
    const bf16* P = (const bf16*)(p.ws + WS_P); unsigned* YLP = (unsigned*)(p.ws + WS_YLP);
    float* SA = (float*)(p.ws + WS_SUM); float* SB = SA + NB * 32 * 1024;
    const bf16* waT = (const bf16*)(p.ws + WS_LRUW); const bf16* wxT = waT + 8 * 128 * 128;
    for (int unit = vcu; unit < 256; unit += G) {
        int tid = threadIdx.x; asm volatile("" : "+v"(tid));
        const int lane = tid & 63, w = __builtin_amdgcn_readfirstlane(tid >> 6), l31 = lane & 31, hi = lane >> 5;
        const int b = unit >> 6, n = (unit & 63) >> 1, half = unit & 1;
        const int row0 = b * SEQ + n * 128;
        __syncthreads();
        { const int tg = tid >> 6, cg = tid & 63, chc = half * 512 + 8 * cg;
            f32x4 cwv[5][2];
#pragma unroll
            for (int q = 0; q < 4; ++q) { cwv[q][0] = *(const f32x4*)(p.conv_w + ((size_t)l * 4 + q) * D + chc); cwv[q][1] = *(const f32x4*)(p.conv_w + ((size_t)l * 4 + q) * D + chc + 4); }
            cwv[4][0] = *(const f32x4*)(p.conv_b + l * D + chc); cwv[4][1] = *(const f32x4*)(p.conv_b + l * D + chc + 4);
#pragma unroll
            for (int pp = 0; pp < 4; ++pp) { const int t0 = row0 + 32 * pp + 4 * tg;
                v4u xr[7];
#pragma unroll
                for (int i = 0; i < 7; ++i) { xr[i] = (v4u){0u, 0u, 0u, 0u}; if (n > 0 || pp > 0 || tg > 0 || i >= 3) xr[i] = *(const v4u*)(P + (size_t)(t0 - 3 + i) * INW + C_LX + chc); }
#pragma unroll
                for (int k = 0; k < 4; ++k) { v4u o;
#pragma unroll
                    for (int d2 = 0; d2 < 4; ++d2) { float r2[2];
#pragma unroll
                        for (int e = 0; e < 2; ++e) { const int cc = 2 * d2 + e; float acc = cwv[4][cc >> 2][cc & 3];
#pragma unroll
                            for (int q = 0; q < 4; ++q) { const unsigned wd = xr[k + q][d2]; acc += cwv[q][cc >> 2][cc & 3] * (e ? bf2f(wd >> 16) : bf2f(wd & 0xffffu)); }
                            r2[e] = acc; }
                        o[d2] = pk2(r2[0], r2[1]); }
                    *(LAS v4u*)(lds + LX_XC + (cg >> 4) * (128 * XC_STRIDE) + (32 * pp + 4 * tg + k) * XC_STRIDE + (cg & 15) * 16) = o; } } }
        __syncthreads();
        const int hbl = w >> 1, jb = (w & 1) * 64, hb = half * 4 + hbl;
#pragma unroll 1
        for (int dh = 0; dh < 2; ++dh) {
            const int jcol = jb + dh * 32 + l31, col = hb * 128 + jcol;
            const float nba = -LOG2E * p.lru_ba[l * D + col], nbx = -LOG2E * p.lru_bx[l * D + col];
            const float kk_v = -8.0f * log1pf(__expf(-p.lru_lambda[l * D + col]));
            const float kk2 = kk_v * LOG2E, kke = 2.0f * kk_v;
            bf16x8 bwa[8], bwx[8];
#pragma unroll
            for (int ks = 0; ks < 8; ++ks) { bwa[ks] = *(const bf16x8*)(waT + ((size_t)hb * 128 + jcol) * 128 + 8 * hi + 16 * ks); bwx[ks] = *(const bf16x8*)(wxT + ((size_t)hb * 128 + jcol) * 128 + 8 * hi + 16 * ks); }
            float hrun = 0.f, prun = 1.f;
#pragma unroll 1
            for (int c = 0; c < 4; ++c) {
                f32x16 ra = (f32x16){}, ia = (f32x16){};
                const LAS unsigned char* xt = lds + LX_XC + hbl * (128 * XC_STRIDE) + (32 * c) * XC_STRIDE;
#pragma unroll
                for (int ks = 0; ks < 8; ++ks) { const bf16x8 af = *(const LAS bf16x8*)(xt + l31 * XC_STRIDE + (16 * ks + 8 * hi) * 2);
                    ra = __builtin_amdgcn_mfma_f32_32x32x16_bf16(af, bwa[ks], ra, 0, 0, 0); ia = __builtin_amdgcn_mfma_f32_32x32x16_bf16(af, bwx[ks], ia, 0, 0, 0); }
                const unsigned rb = (unsigned)(row0 + 32 * c + 4 * hi), offP = (rb * INW + C_LGB + 2 * col) * 2u, offY = (rb * D + col) * 4u;
                unsigned lgb[16];
#pragma unroll
                for (int r = 0; r < 16; ++r) { const unsigned rk = (r & 3) + 8 * (r >> 2); lgb[r] = *(const unsigned*)((const char*)P + (offP + rk * (INW * 2))); }
                float av[16], bv[16];
                const LAS unsigned short* xcol = (const LAS unsigned short*)xt + jcol;
#pragma unroll
                for (int r = 0; r < 16; r += 2) {
                    const int tok = (r & 3) + 8 * (r >> 2) + 4 * hi;
                    const f32x2 zr = (f32x2){ra[r], ra[r + 1]}, zi = (f32x2){ia[r], ia[r + 1]};
                    const f32x2 er = ex2_2(zr * (-LOG2E) + nba), ei = ex2_2(zi * (-LOG2E) + nbx);
                    const f32x2 rr = rcp_2(er + 1.0f), ii = rcp_2(ei + 1.0f);
                    const f32x2 a = ex2_2(rr * kk2);
                    const f32x2 e2 = rr * kke;
                    const f32x2 omp = (e2 * 0.5f + 1.0f) * (-e2), omd = 1.0f - a * a;
                    f32x2 om; om.x = e2.x > -0.02f ? omp.x : omd.x; om.y = e2.y > -0.02f ? omp.y : omd.y;
                    const f32x2 xc = (f32x2){bf2f(xcol[tok * (XC_STRIDE / 2)]), bf2f(xcol[(tok + 1) * (XC_STRIDE / 2)])};
                    const f32x2 bb = sqrt_2(om) * (ii * xc);
                    av[r] = a.x; av[r + 1] = a.y; bv[r] = bb.x; bv[r + 1] = bb.y; }
                float Ag[4], Bg[4], Ap[4], Bp[4];
#pragma unroll
                for (int g = 0; g < 4; ++g) { float A = av[4 * g], B = bv[4 * g];
#pragma unroll
                    for (int e = 1; e < 4; ++e) { B = av[4 * g + e] * B + bv[4 * g + e]; A *= av[4 * g + e]; }
                    Ag[g] = A; Bg[g] = B; Ap[g] = __shfl_xor(A, 32); Bp[g] = __shfl_xor(B, 32); }
                float hs = hrun, ps = prun, stt[4], ptt[4];
#pragma unroll
                for (int g = 0; g < 4; ++g) { const float A0 = hi ? Ap[g] : Ag[g], B0 = hi ? Bp[g] : Bg[g], A1 = hi ? Ag[g] : Ap[g], B1 = hi ? Bg[g] : Bp[g];
                    const float s0 = hs, q0 = ps; hs = A0 * hs + B0; ps *= A0; const float s1 = hs, q1 = ps; hs = A1 * hs + B1; ps *= A1; stt[g] = hi ? s1 : s0; ptt[g] = hi ? q1 : q0; }
                hrun = hs; prun = ps;
#pragma unroll
                for (int g = 0; g < 4; ++g) { float h = stt[g], pc = ptt[g];
#pragma unroll
                    for (int e = 0; e < 4; e += 2) { const int r = 4 * g + e;
                        h = av[r] * h + bv[r]; pc *= av[r]; const float h0 = h, p0 = pc; h = av[r + 1] * h + bv[r + 1]; pc *= av[r + 1];
                        const f32x2 lg = (f32x2){bf2f(lgb[r] & 0xffffu), bf2f(lgb[r + 1] & 0xffffu)}, gb = (f32x2){__uint_as_float(lgb[r] & 0xffff0000u), __uint_as_float(lgb[r + 1] & 0xffff0000u)};
                        const f32x2 u2 = (lg * lg * (0.044715f * 1.5957691216057308f) + 1.5957691216057308f) * lg;
                        const f32x2 gg = lg * rcp_2((ex2_2(gb * (-LOG2E)) + 1.0f) * (ex2_2(u2 * (-LOG2E)) + 1.0f));
                        const unsigned o = offY + ((r & 3) + 8 * (r >> 2)) * (D * 4);
                        *(unsigned*)((char*)YLP + o) = pk2(gg.x * h0, gg.x * p0); *(unsigned*)((char*)YLP + o + D * 4) = pk2(gg.y * h, gg.y * pc); } }
            }
            if (hi == 0) { const size_t o = ((size_t)b * 32 + n) * 1024 + col; SA[o] = prun; SB[o] = hrun; }
        }
    }
}

constexpr int KS_STRIDE = 144;
constexpr int VT_STRIDE = 520;
constexpr int LB_K = 0, LB_V = 256 * KS_STRIDE  , LB_TBL = LB_V + 64 * VT_STRIDE  , LB_CARRY = LB_TBL + 8 * 192 * 4  , LB_END = LB_CARRY + 2048;
static_assert(LB_END <= RING_BYTES && LX_END <= LDSCTL_OFF, "phase B LDS");
__device__ __forceinline__ void phase_attn(const Ptrs& p, int l, LAS unsigned char* lds, int vcu, int G) {
    const bf16* P = (const bf16*)(p.ws + WS_P); bf16* Y = (bf16*)(p.ws + WS_Y); const unsigned* YLP = (const unsigned*)(p.ws + WS_YLP);
    const float* SA = (const float*)(p.ws + WS_SUM); const float* SB = SA + NB * 32 * 1024;
    for (int unit = vcu; unit < 256; unit += G) {
        int tid = threadIdx.x; asm volatile("" : "+v"(tid));
        const int lane = tid & 63, w = __builtin_amdgcn_readfirstlane(tid >> 6), l31 = lane & 31, hi = lane >> 5;
        const int b = unit >> 6, n = (unit & 63) >> 1, half = unit & 1;
        const int row0 = b * SEQ + n * 128;
        __syncthreads();
#pragma unroll
        for (int it = 0; it < 4; ++it) { const int idx = it * 512 + tid, r = idx >> 3, ch = idx & 7;
            v4u v = (v4u){0u, 0u, 0u, 0u};
            if (n > 0 || r >= 128) v = *(const v4u*)(P + (size_t)(row0 - 128 + r) * INW + C_K + half * 64 + ch * 8);
            *(LAS v4u*)(lds + LB_K + r * KS_STRIDE + ch * 16) = v; }
        { const int kg = tid >> 3, dc = tid & 7; v4u v[4];
#pragma unroll
            for (int i = 0; i < 4; ++i) { const int r = 4 * kg + i; v[i] = (v4u){0u, 0u, 0u, 0u};
                if (n > 0 || r >= 128) v[i] = *(const v4u*)(P + (size_t)(row0 - 128 + r) * INW + C_V + half * 64 + dc * 8); }
#pragma unroll
            for (int d2 = 0; d2 < 4; ++d2) {
                const unsigned a0 = v[0][d2], a1 = v[1][d2], a2 = v[2][d2], a3 = v[3][d2];
                u32x2 lo, hh; lo.x = (a0 & 0xffffu) | (a1 << 16); lo.y = (a2 & 0xffffu) | (a3 << 16); hh.x = (a0 >> 16) | (a1 & 0xffff0000u); hh.y = (a2 >> 16) | (a3 & 0xffff0000u);
                *(LAS u32x2*)(lds + LB_V + (dc * 8 + 2 * d2) * VT_STRIDE + kg * 8) = lo; *(LAS u32x2*)(lds + LB_V + (dc * 8 + 2 * d2 + 1) * VT_STRIDE + kg * 8) = hh; } }
#pragma unroll
        for (int i = 0; i < 3; ++i) { const int idx = tid + 512 * i, hd = idx / 192, xi = idx % 192, xx = xi - 32;
            float v = -INFINITY; if (xx >= 0 && xx < 128) v = p.rel_bias[c_bucket[127 - xx] * 16 + half * 8 + hd] * LOG2E;
            ((LAS float*)(lds + LB_TBL))[idx] = v; }
        {
            const size_t o0 = (size_t)b * 32 * 1024 + half * 512 + tid; float h = 0.f; int q = 0;
            for (; q + 8 <= n; q += 8) { float a8[8], b8[8];
#pragma unroll
                for (int u = 0; u < 8; ++u) { a8[u] = SA[o0 + (size_t)(q + u) * 1024]; b8[u] = SB[o0 + (size_t)(q + u) * 1024]; }
#pragma unroll
                for (int u = 0; u < 8; ++u) h = a8[u] * h + b8[u]; }
            for (; q < n; ++q) h = SA[o0 + (size_t)q * 1024] * h + SB[o0 + (size_t)q * 1024];
            ((LAS float*)(lds + LB_CARRY))[tid] = h; }
        __syncthreads();
        const int hq = half * 8 + w;
        const float sink2 = p.attn_sink[l * 16 + hq] * LOG2E;
        const float cy0 = ((const LAS float*)(lds + LB_CARRY))[w * 64 + l31], cy1 = ((const LAS float*)(lds + LB_CARRY))[w * 64 + 32 + l31];
#pragma unroll 1
        for (int c = 0; c < 4; ++c) {
            bf16x8 qr[4];
#pragma unroll
            for (int ks = 0; ks < 4; ++ks) qr[ks] = *(const bf16x8*)(P + (size_t)(row0 + 32 * c + l31) * INW + C_Q + hq * 64 + 16 * ks + 8 * hi);
            f32x16 st[5];
#pragma unroll
            for (int jj = 0; jj < 5; ++jj) { st[jj] = (f32x16){};
#pragma unroll
                for (int ks = 0; ks < 4; ++ks) { const bf16x8 kf = *(const LAS bf16x8*)(lds + LB_K + (32 * (c + jj) + l31) * KS_STRIDE + (16 * ks + 8 * hi) * 2);
                    st[jj] = __builtin_amdgcn_mfma_f32_32x32x16_bf16(kf, qr[ks], st[jj], 0, 0, 0); } }
            const LAS float* tb = (const LAS float*)(lds + LB_TBL) + w * 192 + (31 - l31 + 4 * hi);
            float m = sink2;
#pragma unroll
            for (int jj = 0; jj < 5; ++jj) { const bool dead = (n == 0) && (c + jj < 4);
#pragma unroll
                for (int r = 0; r < 16; ++r) { float v = st[jj][r] * (0.125f * LOG2E) + tb[32 * jj + (r & 3) + 8 * (r >> 2)]; if (dead) v = -INFINITY; st[jj][r] = v; m = fmaxf(m, v); } }
            m = fmaxf(m, __shfl_xor(m, 32));
            float sum = 0.f;
#pragma unroll
            for (int jj = 0; jj < 5; ++jj)
#pragma unroll
                for (int r = 0; r < 16; ++r) { const float e = __builtin_amdgcn_exp2f(st[jj][r] - m); st[jj][r] = e; sum += e; }
            sum += __shfl_xor(sum, 32);
            const float inv = __builtin_amdgcn_rcpf(sum + __builtin_amdgcn_exp2f(sink2 - m));
            const unsigned rb = (unsigned)(row0 + 32 * c + 4 * hi);
            const unsigned colA = (unsigned)(half * 512 + w * 64 + l31);
            const unsigned offP = (rb * INW + C_GA + colA) * 2u, offY = (rb * D + colA) * 2u;
            unsigned short gav[2][16]; unsigned ylp[2][16];
            asm volatile("" ::: "memory");
#pragma unroll
            for (int r = 0; r < 16; ++r) { const unsigned rk = (r & 3) + 8 * (r >> 2); gav[0][r] = LD16(P, offP + rk * (INW * 2)); ylp[0][r] = *(const unsigned*)((const char*)YLP + (2u * offY + rk * (D * 4))); }
            f32x16 O[2]; O[0] = (f32x16){}; O[1] = (f32x16){};
#pragma unroll
            for (int jj = 0; jj < 5; ++jj)
#pragma unroll
                for (int s2 = 0; s2 < 2; ++s2) {
                    v4u pw; pw.x = pk2(st[jj][8 * s2 + 0] * inv, st[jj][8 * s2 + 1] * inv); pw.y = pk2(st[jj][8 * s2 + 2] * inv, st[jj][8 * s2 + 3] * inv);
                    pw.z = pk2(st[jj][8 * s2 + 4] * inv, st[jj][8 * s2 + 5] * inv); pw.w = pk2(st[jj][8 * s2 + 6] * inv, st[jj][8 * s2 + 7] * inv);
                    const bf16x8 pa = __builtin_bit_cast(bf16x8, pw);
                    const int key0 = 32 * (c + jj) + 16 * s2 + 4 * hi;
#pragma unroll
                    for (int dh = 0; dh < 2; ++dh) { const LAS unsigned char* vp = lds + LB_V + (dh * 32 + l31) * VT_STRIDE + key0 * 2;
                        const u32x2 lo = *(const LAS u32x2*)vp, h2 = *(const LAS u32x2*)(vp + 16);
                        v4u vw; vw.x = lo.x; vw.y = lo.y; vw.z = h2.x; vw.w = h2.y;
                        O[dh] = __builtin_amdgcn_mfma_f32_32x32x16_bf16(pa, __builtin_bit_cast(bf16x8, vw), O[dh], 0, 0, 0); } }
            asm volatile("" ::: "memory");
#pragma unroll
            for (int r = 0; r < 16; ++r) { const unsigned rk = (r & 3) + 8 * (r >> 2); gav[1][r] = LD16(P, offP + 64u + rk * (INW * 2)); ylp[1][r] = *(const unsigned*)((const char*)YLP + (2u * offY + 128u + rk * (D * 4))); }
#pragma unroll
            for (int dh = 0; dh < 2; ++dh) { const float cy = dh ? cy1 : cy0;
#pragma unroll
                for (int r = 0; r < 16; ++r) { const unsigned rk = (r & 3) + 8 * (r >> 2);
                    const float y = fast_sigmoid(bf2f(gav[dh][r])) * O[dh][r] + bf2f(ylp[dh][r] & 0xffffu) + __uint_as_float(ylp[dh][r] & 0xffff0000u) * cy;
                    *(unsigned short*)((char*)Y + (offY + 64u * dh + rk * (D * 2))) = (unsigned short)f2bf(y); } }
        }
    }
}

template <bool DRY>
__device__ __forceinline__ void phase_ln1(const Ptrs& p, int l, LAS unsigned char* lds, int gw, int NGW, int tid, int lane) {
    LAS float* rwT = (LAS float*)lds;
    for (int i = tid; i < D * NE; i += 512) rwT[(i & 15) * D + (i >> 4)] = p.router_w[i];
    __syncthreads();
    const float* xin = (l == 0) ? p.x : p.out; float* xout = DRY ? (float*)(p.ws + WS_TA) : p.out;
    const bf16* Z = (const bf16*)(p.ws + WS_H); bf16* U = DRY ? (bf16*)(p.ws + WS_TI) : (bf16*)(p.ws + WS_U);
    const float* mod_l = (const float*)(p.ws + WS_MOD) + (size_t)l * NB * 6144;
    int* eidx = (int*)(p.ws + (DRY ? WS_TZ : WS_EIDX)); float* ew = (float*)(p.ws + (DRY ? WS_TZ + MiB : WS_EW)); int* list = (int*)(p.ws + (DRY ? WS_TZ + 2 * MiB : WS_LIST));
    unsigned* cnt = (unsigned*)(p.ws + WS_CTL) + CW_CNT + l * 1024 + (DRY ? 8192 : 0);
    const float* g = p.ln1_g + l * D; const float* bt = p.ln1_b + l * D;
    LAS int* lcnt = (LAS int*)(lds + 65536); LAS int* lbase = lcnt + 16; LAS int* wrec = lcnt + 32 + (tid >> 6) * 32;
    const int nIt = (T + NGW - 1) / NGW;
    for (int it0 = 0; it0 < nIt; it0 += 8) {
    if (tid < 16) lcnt[tid] = 0;
    __syncthreads();
    f32x4 xq[4]; u32x2 zq[4];
    { const int row = gw + it0 * NGW; if (row < T) {
#pragma unroll
        for (int j = 0; j < 4; ++j) { const int col = 4 * lane + 256 * j; xq[j] = *(const f32x4*)(xin + (size_t)row * D + col); zq[j] = *(const u32x2*)(Z + (size_t)row * D + col); } } }
#pragma unroll 1
    for (int kk = 0; kk < 8; ++kk) { const int row = gw + (it0 + kk) * NGW; if (row >= T) break;
        const float* m = mod_l + (size_t)(row / SEQ) * 6144;
        f32x4 xc_[4]; u32x2 zc_[4];
#pragma unroll
        for (int j = 0; j < 4; ++j) { xc_[j] = xq[j]; zc_[j] = zq[j]; }
        { const int rown = row + NGW; if (kk + 1 < 8 && rown < T) {
#pragma unroll
            for (int j = 0; j < 4; ++j) { const int col = 4 * lane + 256 * j; xq[j] = *(const f32x4*)(xin + (size_t)rown * D + col); zq[j] = *(const u32x2*)(Z + (size_t)rown * D + col); } } }
        f32x4 v[4]; float s = 0.f;
#pragma unroll
        for (int j = 0; j < 4; ++j) { const int col = 4 * lane + 256 * j; const f32x4 xv = xc_[j], g1 = *(const f32x4*)(m + 2048 + col);
            const u32x2 zz = zc_[j];
            const f32x4 zf = (f32x4){bf2f(zz.x & 0xffffu), bf2f(zz.x >> 16), bf2f(zz.y & 0xffffu), bf2f(zz.y >> 16)};
            v[j] = xv * ALPHA + g1 * zf; s += (v[j][0] + v[j][1]) + (v[j][2] + v[j][3]); }
        const float mean = wave_sum(s) * (1.f / D); float q = 0.f;
#pragma unroll
        for (int j = 0; j < 4; ++j) { v[j] = v[j] - mean; q += (v[j][0] * v[j][0] + v[j][1] * v[j][1]) + (v[j][2] * v[j][2] + v[j][3] * v[j][3]); }
        const float rstd = 1.0f / sqrtf(wave_sum(q) * (1.f / D) + LN_EPS);
        float lg[16];
#pragma unroll
        for (int e = 0; e < 16; ++e) lg[e] = 0.f;
#pragma unroll
        for (int j = 0; j < 4; ++j) { const int col = 4 * lane + 256 * j; const f32x4 gm = *(const f32x4*)(g + col), be = *(const f32x4*)(bt + col);
            const f32x4 xn = v[j] * rstd * gm + be; *(f32x4*)(xout + (size_t)row * D + col) = xn;
            const f32x4 sc = *(const f32x4*)(m + 4096 + col), sh = *(const f32x4*)(m + 3072 + col); const f32x4 uu = xn * (sc + 1.0f) + sh;
            u32x2 o; o.x = pk2(uu[0], uu[1]); o.y = pk2(uu[2], uu[3]); *(u32x2*)(U + (size_t)row * D + col) = o;
#pragma unroll
            for (int e = 0; e < 16; ++e) { const f32x4 rw = *(const LAS f32x4*)(rwT + e * D + col); lg[e] += (uu[0] * rw[0] + uu[1] * rw[1]) + (uu[2] * rw[2] + uu[3] * rw[3]); }
            asm volatile("" ::: "memory"); }
#pragma unroll
        for (int e = 0; e < 16; ++e) lg[e] = wave_sum(lg[e]);
        float sc[16]; float mx = -INFINITY;
#pragma unroll
        for (int e = 0; e < 16; ++e) { sc[e] = lg[e] + p.router_b[e]; mx = fmaxf(mx, sc[e]); }
        float sum = 0.f;
#pragma unroll
        for (int e = 0; e < 16; ++e) { sc[e] = __expf(sc[e] - mx); sum += sc[e]; }
        const float isum = 1.0f / sum;
#pragma unroll
        for (int e = 0; e < 16; ++e) sc[e] *= isum;
        int gsel = 0, bi0 = 0, bi1 = 1; float best = -1.f, bw0 = 0.f, bw1 = 0.f;
#pragma unroll
        for (int gI = 0; gI < 4; ++gI) {
            int i0 = 0; float w0 = sc[gI * 4];
#pragma unroll
            for (int k = 1; k < 4; ++k) if (sc[gI * 4 + k] > w0) { w0 = sc[gI * 4 + k]; i0 = k; }
            int i1 = -1; float w1 = -1.f;
#pragma unroll
            for (int k = 0; k < 4; ++k) if (k != i0 && sc[gI * 4 + k] > w1) { w1 = sc[gI * 4 + k]; i1 = k; }
            const float gs = w0 + w1;
            if (gs > best) { best = gs; gsel = gI; bi0 = i0; bi1 = i1; bw0 = w0; bw1 = w1; }
        }
        if (lane == 0) {
            const float wsum = bw0 + bw1; const int e0 = gsel * 4 + bi0, e1 = gsel * 4 + bi1;
            eidx[row * 2 + 0] = e0; eidx[row * 2 + 1] = e1; ew[row * 2 + 0] = bw0 / wsum; ew[row * 2 + 1] = bw1 / wsum;
            wrec[kk * 4 + 0] = e0; wrec[kk * 4 + 1] = __hip_atomic_fetch_add(lcnt + e0, 1, __ATOMIC_RELAXED, __HIP_MEMORY_SCOPE_WORKGROUP);
            wrec[kk * 4 + 2] = e1; wrec[kk * 4 + 3] = __hip_atomic_fetch_add(lcnt + e1, 1, __ATOMIC_RELAXED, __HIP_MEMORY_SCOPE_WORKGROUP);
        }
    }
    __syncthreads();
    if (tid < 16) lbase[tid] = (int)__hip_atomic_fetch_add(cnt + 64 * tid, (unsigned)lcnt[tid], __ATOMIC_RELAXED, __HIP_MEMORY_SCOPE_AGENT);
    __syncthreads();
    if (lane < 8) { const int row = gw + (it0 + lane) * NGW;
        if (row < T) { const int e0 = wrec[lane * 4 + 0], r0 = wrec[lane * 4 + 1], e1 = wrec[lane * 4 + 2], r1 = wrec[lane * 4 + 3];
            list[e0 * 16384 + lbase[e0] + r0] = row * 2 + 0; list[e1 * 16384 + lbase[e1] + r1] = row * 2 + 1; } }
    __syncthreads();
    }
}
template <bool DRY>
__device__ __forceinline__ void phase_ln2(const Ptrs& p, int l, int gw, int NGW, int lane) {
    float* x = p.out; float* xo = DRY ? (float*)(p.ws + WS_TA) : p.out; const bf16* F0 = (const bf16*)(p.ws + WS_P); const bf16* F1 = F0 + (size_t)T * D; bf16* U = (bf16*)(p.ws + WS_U);
    const float* mod_l = (const float*)(p.ws + WS_MOD) + (size_t)l * NB * 6144; const float* mod_n = mod_l + NB * 6144;
    const float* ew = (const float*)(p.ws + WS_EW); if (DRY) U = (bf16*)(p.ws + WS_TI);
    const float* g = p.ln2_g + l * D; const float* bt = p.ln2_b + l * D;
    f32x4 xq[4]; u32x2 aq[4], cq[4]; float wq = 0.f;
    if (gw < T) { wq = ew[gw * 2 + (lane & 1)];
#pragma unroll
        for (int j = 0; j < 4; ++j) { const int col = 4 * lane + 256 * j; xq[j] = *(const f32x4*)(x + (size_t)gw * D + col); aq[j] = *(const u32x2*)(F0 + (size_t)gw * D + col); cq[j] = *(const u32x2*)(F1 + (size_t)gw * D + col); } }
#pragma unroll 1
    for (int row = gw; row < T; row += NGW) {
        const float* m = mod_l + (size_t)(row / SEQ) * 6144; const float* mn = mod_n + (size_t)(row / SEQ) * 6144;
        const float wv = wq;
        f32x4 xc_[4]; u32x2 ac_[4], cc_[4];
#pragma unroll
        for (int j = 0; j < 4; ++j) { xc_[j] = xq[j]; ac_[j] = aq[j]; cc_[j] = cq[j]; }
        { const int rown = row + NGW; if (rown < T) { wq = ew[rown * 2 + (lane & 1)];
#pragma unroll
            for (int j = 0; j < 4; ++j) { const int col = 4 * lane + 256 * j; xq[j] = *(const f32x4*)(x + (size_t)rown * D + col); aq[j] = *(const u32x2*)(F0 + (size_t)rown * D + col); cq[j] = *(const u32x2*)(F1 + (size_t)rown * D + col); } } }
        const float w0 = __int_as_float(__builtin_amdgcn_readlane(__float_as_int(wv), 0)), w1 = __int_as_float(__builtin_amdgcn_readlane(__float_as_int(wv), 1));
        f32x4 v[4]; float s = 0.f;
#pragma unroll
        for (int j = 0; j < 4; ++j) { const int col = 4 * lane + 256 * j; const f32x4 xv = xc_[j], g2 = *(const f32x4*)(m + 5120 + col);
            const u32x2 a = ac_[j], c2 = cc_[j];
            const f32x4 f = (f32x4){bf2f(a.x & 0xffffu), bf2f(a.x >> 16), bf2f(a.y & 0xffffu), bf2f(a.y >> 16)} * w0 + (f32x4){bf2f(c2.x & 0xffffu), bf2f(c2.x >> 16), bf2f(c2.y & 0xffffu), bf2f(c2.y >> 16)} * w1;
            v[j] = xv * ALPHA + g2 * f; s += (v[j][0] + v[j][1]) + (v[j][2] + v[j][3]); }
        const float mean = wave_sum(s) * (1.f / D); float q = 0.f;
#pragma unroll
        for (int j = 0; j < 4; ++j) { v[j] = v[j] - mean; q += (v[j][0] * v[j][0] + v[j][1] * v[j][1]) + (v[j][2] * v[j][2] + v[j][3] * v[j][3]); }
        const float rstd = 1.0f / sqrtf(wave_sum(q) * (1.f / D) + LN_EPS);
#pragma unroll
        for (int j = 0; j < 4; ++j) { const int col = 4 * lane + 256 * j; const f32x4 gm = *(const f32x4*)(g + col), be = *(const f32x4*)(bt + col);
            const f32x4 xn = v[j] * rstd * gm + be; *(f32x4*)(xo + (size_t)row * D + col) = xn;
            if (l + 1 < NL) { const f32x4 sh = *(const f32x4*)(mn + col), sc = *(const f32x4*)(mn + 1024 + col); const f32x4 uu = xn * (sc + 1.0f) + sh;
                u32x2 o; o.x = pk2(uu[0], uu[1]); o.y = pk2(uu[2], uu[3]); *(u32x2*)(U + (size_t)row * D + col) = o; } }
    }
}
constexpr int N_PHASES = 2 + 8 * NL;
#ifndef REP_A
#define REP_A 1
#endif
#ifndef REP_B1
#define REP_B1 1
#endif
#ifndef REP_B2
#define REP_B2 1
#endif
#ifndef REP_C
#define REP_C 1
#endif
#ifndef REP_D
#define REP_D 1
#endif
#ifndef REP_E
#define REP_E 1
#endif
#ifndef REP_C2
#define REP_C2 1
#endif
#ifndef REP_F
#define REP_F 1
#endif
#ifndef REP_CV
#define REP_CV 1
#endif
#ifndef REP_P0
#define REP_P0 1
#endif
struct Args { const float* in[24]; float* out; unsigned char* ws; int ph_lo, ph_hi; };
__global__ void __launch_bounds__(NWAVES * 64, 2) fwd(Args args) {
    extern __shared__ __attribute__((aligned(16))) unsigned char lds_raw[];
    LAS unsigned char* lds = (LAS unsigned char*)lds_raw;
    const int tid = threadIdx.x, lane = tid & 63, wave = __builtin_amdgcn_readfirstlane(tid >> 6);
    const int G = gridDim.x, bx = blockIdx.x, vcu = (G % 8 == 0) ? (bx % 8) * (G / 8) + bx / 8 : bx;
    const int gw = vcu * NWAVES + wave, NGW = G * NWAVES;
    Ptrs p;
    p.x = args.in[0]; p.c = args.in[1]; p.ada_w = args.in[2]; p.ada_b = args.in[3]; p.w_in = args.in[4]; p.attn_sink = args.in[5]; p.rel_bias = args.in[6]; p.conv_w = args.in[7]; p.conv_b = args.in[8];
    p.lru_wa = args.in[9]; p.lru_ba = args.in[10]; p.lru_wx = args.in[11]; p.lru_bx = args.in[12]; p.lru_lambda = args.in[13]; p.w_out = args.in[14]; p.ln1_g = args.in[15]; p.ln1_b = args.in[16];
    p.router_w = args.in[17]; p.router_b = args.in[18]; p.moe_wg = args.in[19]; p.moe_wu = args.in[20]; p.moe_wd = args.in[21]; p.ln2_g = args.in[22]; p.ln2_b = args.in[23];
    p.out = args.out; p.ws = args.ws;
    LAS unsigned* ctlw = (LAS unsigned*)(lds + LDSCTL_OFF);
    for (int u = tid; u < 256; u += NWAVES * 64) ctlw[u] = 0u;
    __syncthreads();
    const int lo = args.ph_lo, hi = args.ph_hi;
    XcdBarrier bar; bar.bar = (unsigned*)(p.ws + WS_CTL) + CW_BAR; bar.x = 0; bar.st = nullptr;
    if (hi - lo > 1) bar = xcd_barrier_post((unsigned*)(p.ws + WS_CTL) + CW_BAR, (volatile LAS unsigned*)(ctlw + 16));
#define IN(k) (lo <= (k) && (k) < hi)
#define LAUNDER_TID() int tidp = threadIdx.x; asm volatile("" : "+v"(tidp)); const int lanep = tidp & 63, wavep = __builtin_amdgcn_readfirstlane(tidp >> 6), gwp = vcu * NWAVES + wavep; (void)lanep; (void)gwp
#define SEAM(k) do { if (IN(k) && IN((k) + 1)) xcd_barrier(bar); } while (0)
    bf16* U = (bf16*)(p.ws + WS_U); bf16* Pb = (bf16*)(p.ws + WS_P); bf16* Yb = (bf16*)(p.ws + WS_Y); bf16* Hb = (bf16*)(p.ws + WS_H);
    const float* mod = (const float*)(p.ws + WS_MOD);

    for (int rep_ = 0; rep_ < REP_P0; ++rep_) {
        if (IN(0)) { LAUNDER_TID(); if (bx < NL * 24) mod_item(p, bx, lds, tidp, wavep, lanep); convert_layer(p, 0, lds, gwp, NGW, wavep, lanep); }
    SEAM(0); }

    if (IN(1)) { LAUNDER_TID(); modulate_rows(p.x, mod, U, gwp, NGW, lanep); }
    SEAM(1);
#pragma unroll 1
    for (int l = 0; l < NL; ++l) {
        const int pb = 2 + 8 * l;
        for (int rep_ = 0; rep_ < REP_A; ++rep_) {
        if (IN(pb + 0)) { LAUNDER_TID(); pg8::Gemm g{U, (const bf16*)(p.ws + WS_WIN), T, INW, D}; pg8::StaticOrder S; S.init(T, INW, G, bx); pg8::EpiStoreBf16 E{Pb, INW};
            pg8::gemm_phase<pg8::EpiStoreBf16, pg8::StaticOrder, true, false>(lds + RING_OFF, g, S, E, tidp); }
        SEAM(pb + 0); }

        for (int rep_ = 0; rep_ < REP_B1; ++rep_) {
        if (IN(pb + 1)) phase_lru(p, l, lds, vcu, G);
        SEAM(pb + 1); }

        for (int rep_ = 0; rep_ < REP_B2; ++rep_) {
        if (IN(pb + 2)) phase_attn(p, l, lds, vcu, G);
        SEAM(pb + 2); }

        for (int rep_ = 0; rep_ < REP_C; ++rep_) {
        if (IN(pb + 3)) { LAUNDER_TID(); pg8::Gemm g{Yb, (const bf16*)(p.ws + WS_WO), T, D, D}; pg8::StaticOrder S; S.init(T, D, G, bx); pg8::EpiStoreBf16 E{Hb, D};
            pg8::gemm_phase<pg8::EpiStoreBf16, pg8::StaticOrder, false, false>(lds + RING_OFF, g, S, E, tidp); }
        SEAM(pb + 3); }

        for (int rep_ = 1; rep_ < REP_C2; ++rep_) { if (IN(pb + 4)) { LAUNDER_TID(); phase_ln1<true>(p, l, lds, gwp, NGW, tidp, lanep); } SEAM(pb + 3); }
        if (IN(pb + 4)) { LAUNDER_TID(); phase_ln1<false>(p, l, lds, gwp, NGW, tidp, lanep); }
        SEAM(pb + 4);
        for (int rep_ = 0; rep_ < REP_D; ++rep_) {
        if (IN(pb + 5)) { LAUNDER_TID();
            if (tidp < 16) ((LAS int*)ctlw)[tidp] = (int)__hip_atomic_load((unsigned*)(p.ws + WS_CTL) + CW_CNT + l * 1024 + 64 * tidp, __ATOMIC_RELAXED, __HIP_MEMORY_SCOPE_AGENT);
            __syncthreads();
            pg8::Gemm g{U, (const bf16*)(p.ws + WS_WGU), T, NE * 1024, D}; pg8::MoeOrder S{(const LAS int*)ctlw, (const int*)(p.ws + WS_LIST), G, vcu}; pg8::EpiMoeGU E{Hb};
            pg8::gemm_phase<pg8::EpiMoeGU, pg8::MoeOrder, true, true>(lds + RING_OFF, g, S, E, tidp); }
        SEAM(pb + 5); }

        for (int rep_ = 0; rep_ < REP_E; ++rep_) {
        if (IN(pb + 6)) { LAUNDER_TID();
            if (tidp < 16) ((LAS int*)ctlw)[tidp] = (int)__hip_atomic_load((unsigned*)(p.ws + WS_CTL) + CW_CNT + l * 1024 + 64 * tidp, __ATOMIC_RELAXED, __HIP_MEMORY_SCOPE_AGENT);
            __syncthreads();
            pg8::Gemm g{Hb, (const bf16*)(p.ws + WS_WD), 36864, NE * 1024, FF}; pg8::MoeOrder S{(const LAS int*)ctlw, (const int*)(p.ws + WS_LIST), G, vcu}; pg8::EpiMoeDown E{Pb, (const int*)(p.ws + WS_LIST), T};
            pg8::gemm_phase<pg8::EpiMoeDown, pg8::MoeOrder, true, false>(lds + RING_OFF, g, S, E, tidp); }
        SEAM(pb + 6); }

        for (int rep_ = 1; rep_ < REP_F; ++rep_) { if (IN(pb + 7)) { LAUNDER_TID(); phase_ln2<true>(p, l, gwp, NGW, lanep); } SEAM(pb + 6); }
        for (int rep_ = 1; rep_ < REP_CV; ++rep_) { if (IN(pb + 7)) { LAUNDER_TID(); if (l + 1 < NL) convert_layer(p, l + 1, lds, gwp, NGW, wavep, lanep); } SEAM(pb + 6); }
        if (IN(pb + 7)) { LAUNDER_TID(); phase_ln2<false>(p, l, gwp, NGW, lanep); if (l + 1 < NL) convert_layer(p, l + 1, lds, gwp, NGW, wavep, lanep); }
        SEAM(pb + 7);
    }
#undef IN
#undef SEAM
}
#ifndef MK_SPLIT
#define MK_SPLIT 0
#endif
extern "C" void kernel_launch(void* const* d_in, const int* in_sizes, int n_in, void* d_out, int out_size, void* d_ws, size_t ws_size, hipStream_t stream) {
    static int grid = 0;
    if (grid == 0) {
        if (n_in != 24 || in_sizes[0] != T * D || out_size != T * D || ws_size < WS_END) { fprintf(stderr, "kernel_launch: unexpected shapes (n_in %d, in0 %d, out %d, ws %zu); nothing launched\n", n_in, n_in > 0 ? in_sizes[0] : -1, out_size, ws_size); grid = -1; return; }
        int dev = 0, cus = 0, per_cu = 0;
        if (hipGetDevice(&dev) != hipSuccess || hipDeviceGetAttribute(&cus, hipDeviceAttributeMultiprocessorCount, dev) != hipSuccess) { fprintf(stderr, "kernel_launch: device query failed\n"); grid = -1; return; }
        if (hipFuncSetAttribute((const void*)fwd, hipFuncAttributeMaxDynamicSharedMemorySize, LDS_BYTES) != hipSuccess) { fprintf(stderr, "kernel_launch: hipFuncSetAttribute failed\n"); grid = -1; return; }
        if (hipOccupancyMaxActiveBlocksPerMultiprocessor(&per_cu, (const void*)fwd, NWAVES * 64, LDS_BYTES) != hipSuccess || per_cu < 1) fprintf(stderr, "kernel_launch: occupancy query reports %d blocks per CU\n", per_cu);
        (void)hipGetLastError();
        grid = cus;
    }
    if (grid < 0) return;
    if (hipMemsetAsync((char*)d_ws + WS_CTL, 0, CTL_ZERO_BYTES, stream) != hipSuccess) { fprintf(stderr, "kernel_launch: memset failed\n"); return; }
    Args a{};
    for (int i = 0; i < 24; ++i) a.in[i] = (const float*)d_in[i];
    a.out = (float*)d_out; a.ws = (unsigned char*)d_ws;
#if MK_SPLIT
    for (int ph = 0; ph < N_PHASES; ++ph) { a.ph_lo = ph; a.ph_hi = ph + 1; hipLaunchKernelGGL(fwd, dim3(grid), dim3(NWAVES * 64), LDS_BYTES, stream, a); }
#else
    a.ph_lo = 0; a.ph_hi = N_PHASES; hipLaunchKernelGGL(fwd, dim3(grid), dim3(NWAVES * 64), LDS_BYTES, stream, a);
#endif
    const hipError_t le = hipPeekAtLastError();
    if (le != hipSuccess) fprintf(stderr, "kernel_launch: launch failed: %s\n", hipGetErrorName(le));
}
```
